# Optimizing an MI355X kernel written in HIP

```python
import jax, jax.numpy as jnp
from jax import lax
import numpy as np

D_MODEL = 1024
BATCH = 1
SEQ = 16384
DEPTH = 1
DEC_BATCH = 8
DEC_SEQ = 16
PAST_LEN = 1024

CHUNK = 64
N_META = 16
D_LRU = 512
N_LRU_HEADS = 8
LRU_HEAD = D_LRU // N_LRU_HEADS
LRU_C = 8.0
CONV_LRU = 4
D_POOL = 512
POOL_WINDOWS = (2, 4, 8, 16)
N_POOL_GROUPS = len(POOL_WINDOWS)
POOL_GROUP = D_POOL // N_POOL_GROUPS
POOL_BUF = max(POOL_WINDOWS) - 1
D_MIX = D_LRU + D_POOL
D_IN = 2 * D_LRU + D_POOL
D_FF = 3 * D_MODEL
CONV_FFN = 3
EPS = 1e-6

kernel_name = "hymba_rglru_pool_convffn_stream_step"


def rmsnorm(x, g):
    xf = x.astype(jnp.float32)
    y = xf * lax.rsqrt(jnp.mean(xf * xf, axis=-1, keepdims=True) + EPS) * g.astype(jnp.float32)
    return y.astype(x.dtype)


def causal_dwconv(x, buf, w, b):
    width = w.shape[0]
    T = x.shape[1]
    xp = jnp.concatenate([buf.astype(x.dtype), x], axis=1)
    y = xp[:, 0:T] * w[0]
    for k in range(1, width):
        y = y + xp[:, k:k + T] * w[k]
    return y + b, xp[:, xp.shape[1] - (width - 1):]


def rg_lru(x, h0, wa, ba, wx, bx, lam):
    B, T, _ = x.shape
    xh = x.reshape(B, T, N_LRU_HEADS, LRU_HEAD)
    r = jax.nn.sigmoid(jnp.einsum('bthi,hij->bthj', xh, wa).reshape(B, T, D_LRU) + ba)
    i = jax.nn.sigmoid(jnp.einsum('bthi,hij->bthj', xh, wx).reshape(B, T, D_LRU) + bx)
    log_a = (LRU_C * r.astype(jnp.float32)) * jax.nn.log_sigmoid(lam.astype(jnp.float32))
    a = jnp.exp(log_a)
    mult = jnp.sqrt(-jnp.expm1(2.0 * log_a))
    u = mult * (i * x).astype(jnp.float32)

    def combine(left, right):
        a1, b1 = left
        a2, b2 = right
        return a1 * a2, a2 * b1 + b2

    A, Bc = lax.associative_scan(combine, (a, u), axis=1)
    h = A * h0.astype(jnp.float32)[:, None, :] + Bc
    return h.astype(x.dtype), h[:, -1].astype(h0.dtype)


def pool_mixer(x, buf, start_pos, w_pool, b_pool, scale):
    B, T, _ = x.shape
    xf = x.astype(jnp.float32)
    xcat = jnp.concatenate([buf.astype(jnp.float32), xf], axis=1)
    cs = jnp.concatenate([jnp.zeros((B, 1, D_POOL), jnp.float32), jnp.cumsum(xcat, axis=1)], axis=1)
    pos = start_pos + jnp.arange(T)
    means = []
    for g, w in enumerate(POOL_WINDOWS):
        lo, hi = g * POOL_GROUP, (g + 1) * POOL_GROUP
        s = cs[:, POOL_BUF + 1:POOL_BUF + 1 + T, lo:hi] - cs[:, POOL_BUF + 1 - w:POOL_BUF + 1 - w + T, lo:hi]
        cnt = jnp.minimum(pos + 1, w).astype(jnp.float32)[None, :, None]
        means.append(s / cnt)
    m = jnp.concatenate(means, axis=-1) - xf
    mg = m.reshape(B, T, N_POOL_GROUPS, POOL_GROUP)
    y = jnp.einsum('btgc,gcd->btgd', mg, w_pool.astype(jnp.float32)).reshape(B, T, D_POOL)
    y = (y + b_pool.astype(jnp.float32)) * scale.astype(jnp.float32)
    return y.astype(x.dtype), xcat[:, xcat.shape[1] - POOL_BUF:].astype(buf.dtype)


def layer(x, start_pos, st_h, st_conv, st_pool, st_ffn, norm_mix_g, w_in, conv_lru_w, conv_lru_b,
          gate_a_w, gate_a_b, gate_x_w, gate_x_b, lru_lambda, pool_w, pool_b, pool_scale,
          gn_lru, gn_pool, w_out, norm_ffn_g, w_up, ffn_conv_w, ffn_conv_b, w_down):
    u = rmsnorm(x, norm_mix_g) @ w_in
    u_lru = u[..., :D_LRU]
    g_lru = u[..., D_LRU:2 * D_LRU]
    u_pool = u[..., 2 * D_LRU:]
    c, new_conv = causal_dwconv(u_lru, st_conv, conv_lru_w, conv_lru_b)
    h, new_h = rg_lru(c, st_h, gate_a_w, gate_a_b, gate_x_w, gate_x_b, lru_lambda)
    y_lru = h * jax.nn.gelu(g_lru)
    y_pool, new_pool = pool_mixer(u_pool, st_pool, start_pos, pool_w, pool_b, pool_scale)
    mix = jnp.concatenate([rmsnorm(y_lru, gn_lru), rmsnorm(y_pool, gn_pool)], axis=-1) @ w_out
    x = x + mix
    up = rmsnorm(x, norm_ffn_g) @ w_up
    upc, new_ffn = causal_dwconv(up, st_ffn, ffn_conv_w, ffn_conv_b)
    x = x + (jax.nn.gelu(upc[..., :D_FF]) * upc[..., D_FF:]) @ w_down
    return x, new_h, new_conv, new_pool, new_ffn


def run_trunk(x, start_pos, st_h, st_conv, st_pool, st_ffn, weights):
    hs, convs, pools, ffns = [], [], [], []
    for l in range(DEPTH):
        wl = [w[l] for w in weights]
        x, nh, nc, npool, nf = layer(x, start_pos, st_h[l], st_conv[l], st_pool[l], st_ffn[l], *wl)
        hs.append(nh)
        convs.append(nc)
        pools.append(npool)
        ffns.append(nf)
    return x, jnp.stack(hs), jnp.stack(convs), jnp.stack(pools), jnp.stack(ffns)


def setup_inputs(seed: int = 0) -> dict:
    key = jax.random.key(seed)
    ks = jax.random.split(key, 32)
    f32 = jnp.float32
    nrm = lambda k, shape, s: jax.random.normal(k, shape, f32) * s
    u = jax.random.uniform(ks[0], (DEPTH, D_LRU), f32, 0.9, 0.999)
    a0 = u ** (1.0 / LRU_C)
    lru_lambda = jnp.log(a0) - jnp.log1p(-a0)
    return {
        "x_prompt": nrm(ks[1], (BATCH, SEQ, D_MODEL), 1.0),
        "x_sample": nrm(ks[2], (DEC_BATCH, DEC_SEQ, D_MODEL), 1.0),
        "state_lru_h": nrm(ks[3], (DEPTH, DEC_BATCH, D_LRU), 0.5),
        "state_lru_conv": nrm(ks[4], (DEPTH, DEC_BATCH, CONV_LRU - 1, D_LRU), 1.0),
        "state_pool": nrm(ks[5], (DEPTH, DEC_BATCH, POOL_BUF, D_POOL), 1.0),
        "state_ffn_conv": nrm(ks[6], (DEPTH, DEC_BATCH, CONV_FFN - 1, 2 * D_FF), 1.0),
        "meta_tokens": nrm(ks[7], (N_META, D_MODEL), 1.0),
        "norm_mix_g": 1.0 + nrm(ks[8], (DEPTH, D_MODEL), 0.02),
        "w_in": nrm(ks[9], (DEPTH, D_MODEL, D_IN), D_MODEL ** -0.5),
        "conv_lru_w": nrm(ks[10], (DEPTH, CONV_LRU, D_LRU), CONV_LRU ** -0.5),
        "conv_lru_b": nrm(ks[11], (DEPTH, D_LRU), 0.01),
        "gate_a_w": nrm(ks[12], (DEPTH, N_LRU_HEADS, LRU_HEAD, LRU_HEAD), LRU_HEAD ** -0.5),
        "gate_a_b": nrm(ks[13], (DEPTH, D_LRU), 0.01),
        "gate_x_w": nrm(ks[14], (DEPTH, N_LRU_HEADS, LRU_HEAD, LRU_HEAD), LRU_HEAD ** -0.5),
        "gate_x_b": nrm(ks[15], (DEPTH, D_LRU), 0.01),
        "lru_lambda": lru_lambda,
        "pool_w": nrm(ks[16], (DEPTH, N_POOL_GROUPS, POOL_GROUP, POOL_GROUP), POOL_GROUP ** -0.5),
        "pool_b": nrm(ks[17], (DEPTH, D_POOL), 0.01),
        "pool_scale": 1.0 + nrm(ks[18], (DEPTH, D_POOL), 0.02),
        "gn_lru": 1.0 + nrm(ks[19], (DEPTH, D_LRU), 0.02),
        "gn_pool": 1.0 + nrm(ks[20], (DEPTH, D_POOL), 0.02),
        "w_out": nrm(ks[21], (DEPTH, D_MIX, D_MODEL), D_MIX ** -0.5),
        "norm_ffn_g": 1.0 + nrm(ks[22], (DEPTH, D_MODEL), 0.02),
        "w_up": nrm(ks[23], (DEPTH, D_MODEL, 2 * D_FF), D_MODEL ** -0.5),
        "ffn_conv_w": nrm(ks[24], (DEPTH, CONV_FFN, 2 * D_FF), CONV_FFN ** -0.5),
        "ffn_conv_b": nrm(ks[25], (DEPTH, 2 * D_FF), 0.01),
        "w_down": nrm(ks[26], (DEPTH, D_FF, D_MODEL), D_FF ** -0.5),
        "final_norm_g": 1.0 + nrm(ks[27], (D_MODEL,), 0.02),
    }


def reference(x_prompt, x_sample, state_lru_h, state_lru_conv, state_pool, state_ffn_conv,
              meta_tokens, norm_mix_g, w_in, conv_lru_w, conv_lru_b, gate_a_w, gate_a_b,
              gate_x_w, gate_x_b, lru_lambda, pool_w, pool_b, pool_scale, gn_lru, gn_pool,
              w_out, norm_ffn_g, w_up, ffn_conv_w, ffn_conv_b, w_down, final_norm_g):
    weights = (norm_mix_g, w_in, conv_lru_w, conv_lru_b, gate_a_w, gate_a_b, gate_x_w, gate_x_b,
               lru_lambda, pool_w, pool_b, pool_scale, gn_lru, gn_pool, w_out, norm_ffn_g,
               w_up, ffn_conv_w, ffn_conv_b, w_down)
    dt = x_prompt.dtype
    B = x_prompt.shape[0]
    meta = jnp.broadcast_to(meta_tokens.astype(dt)[None], (B, N_META, D_MODEL))
    xp = jnp.concatenate([meta, x_prompt], axis=1)
    z_h = jnp.zeros((DEPTH, B, D_LRU), state_lru_h.dtype)
    z_conv = jnp.zeros((DEPTH, B, CONV_LRU - 1, D_LRU), state_lru_conv.dtype)
    z_pool = jnp.zeros((DEPTH, B, POOL_BUF, D_POOL), state_pool.dtype)
    z_ffn = jnp.zeros((DEPTH, B, CONV_FFN - 1, 2 * D_FF), state_ffn_conv.dtype)
    hp, p_lru_h, p_lru_conv, p_pool, p_ffn_conv = run_trunk(xp, 0, z_h, z_conv, z_pool, z_ffn, weights)
    y_prompt = rmsnorm(hp, final_norm_g)[:, N_META:]
    hs, s_lru_h, s_lru_conv, s_pool, s_ffn_conv = run_trunk(
        x_sample, PAST_LEN, state_lru_h, state_lru_conv, state_pool, state_ffn_conv, weights)
    y_sample = rmsnorm(hs, final_norm_g)
    return (y_prompt, y_sample, p_lru_h, p_lru_conv, p_pool, p_ffn_conv,
            s_lru_h, s_lru_conv, s_pool, s_ffn_conv)
```

```cpp
#include <hip/hip_runtime.h>
#include <cstdio>
#include <cstdint>

#ifndef MK_N_LAUNCHES
#define MK_N_LAUNCHES 1
#endif

#define GAS __attribute__((address_space(1)))
#define LAS __attribute__((address_space(3)))
typedef unsigned short bf16_t;
typedef short bf16x8 __attribute__((ext_vector_type(8)));
typedef float f32x4 __attribute__((ext_vector_type(4)));
typedef float f32x2 __attribute__((ext_vector_type(2)));
typedef unsigned u32x4 __attribute__((ext_vector_type(4)));
typedef unsigned u32x2 __attribute__((ext_vector_type(2)));

constexpr int D = 1024, TP = 16400, NSAMP = 128, MREAL = 16528, MPAD = 16640, NMETA = 16;
constexpr int DIN = 1536, DFF = 3072, DUP = 6144, DLRU = 512;
constexpr int CHUNK = 80, NCHUNK_P = 205, NITEM2 = 213;
constexpr int UROWS = MPAD + 9 * 16;
constexpr float EPS = 1e-6f;
constexpr int NPH = 9;
constexpr size_t O_YP = 0, O_YS = 16777216, O_PH = 16908288, O_PC = 16908800, O_PP = 16910336, O_PF = 16918016,
                 O_SH = 16930304, O_SC = 16934400, O_SP = 16946688, O_SF = 17008128;
constexpr size_t MiB = 1u << 20;
constexpr size_t WS_CTL = 0, CTL_ZERO_BYTES = 1 * MiB;
constexpr size_t WS_WIN = 1 * MiB, WS_WOUT = 4 * MiB, WS_WUP = 6 * MiB, WS_WDN = 18 * MiB;
constexpr size_t WS_WA = 24 * MiB, WS_WX = 24 * MiB + 65536, WS_PW = 24 * MiB + 131072, WS_LSL = 24 * MiB + 262144;
constexpr size_t WS_AGGA = 25 * MiB, WS_AGGH = 25 * MiB + 524288;
constexpr size_t WS_SS1 = 26 * MiB, WS_SS2 = 28 * MiB, WS_HEAD = 30 * MiB, WS_TAIL = 34 * MiB, WS_HEADX = 38 * MiB, WS_TAILX = 39 * MiB;
constexpr size_t WS_XN0 = 40 * MiB, WS_U = 73 * MiB, WS_Z = 123 * MiB, WS_X1 = 156 * MiB, WS_XB1 = 221 * MiB, WS_ACT = 40 * MiB, WS_END = 254 * MiB;
static_assert(WS_XN0 + (size_t)MPAD * D * 2 <= WS_U && WS_U + (size_t)UROWS * DIN * 2 <= WS_Z && WS_Z + (size_t)MPAD * D * 2 <= WS_X1 &&
              WS_X1 + (size_t)MPAD * D * 4 <= WS_XB1 && WS_XB1 + (size_t)MPAD * D * 2 <= WS_END && WS_ACT + (size_t)MPAD * DFF * 2 <= WS_X1, "ws map");
constexpr int CW_BAR = 4096;

#define LDS_WAIT() asm volatile("s_waitcnt lgkmcnt(0)" ::: "memory")
#define VM_WAIT() asm volatile("s_waitcnt vmcnt(0)" ::: "memory")
#define RLX_AGENT __ATOMIC_RELAXED, __HIP_MEMORY_SCOPE_AGENT
__device__ __forceinline__ unsigned f2bf(float f) { unsigned u = __builtin_bit_cast(unsigned, f); return (u + 0x7fffu + ((u >> 16) & 1u)) >> 16; }
__device__ __forceinline__ unsigned pk2(float lo, float hi) { return f2bf(lo) | (f2bf(hi) << 16); }
__device__ __forceinline__ float bflo(unsigned w) { return __builtin_bit_cast(float, w << 16); }
__device__ __forceinline__ float bfhi(unsigned w) { return __builtin_bit_cast(float, w & 0xffff0000u); }
__device__ __forceinline__ void unpack8(const u32x4 w, float (&o)[8]) {
    o[0] = bflo(w.x); o[1] = bfhi(w.x); o[2] = bflo(w.y); o[3] = bfhi(w.y); o[4] = bflo(w.z); o[5] = bfhi(w.z); o[6] = bflo(w.w); o[7] = bfhi(w.w); }
__device__ __forceinline__ u32x4 pack8(const float (&v)[8]) { u32x4 w; w.x = pk2(v[0], v[1]); w.y = pk2(v[2], v[3]); w.z = pk2(v[4], v[5]); w.w = pk2(v[6], v[7]); return w; }
template <int CTRL> __device__ __forceinline__ float dppf(float old, float src) {
    return __builtin_bit_cast(float, __builtin_amdgcn_update_dpp(__builtin_bit_cast(int, old), __builtin_bit_cast(int, src), CTRL, 0xF, 0xF, false)); }
#define DPP_SHR(n) (0x110 + (n))
#define DPP_ROR(n) (0x120 + (n))
__device__ __forceinline__ float fast_sigmoid(float x) { return __builtin_amdgcn_rcpf(1.0f + __builtin_amdgcn_exp2f(-1.4426950408889634f * x)); }
__device__ __forceinline__ float gelu_tanh(float x) {
    const float t = x * (-2.3022081983f + -0.1029432396f * x * x);
    return x * __builtin_amdgcn_rcpf(1.0f + __builtin_amdgcn_exp2f(t)); }
template <class T> __device__ __forceinline__ const T& gld(const void* base, unsigned byteoff) { return *(const T*)((const char*)base + byteoff); }
template <class T> __device__ __forceinline__ T& gst(void* base, unsigned byteoff) { return *(T*)((char*)base + byteoff); }
__device__ __forceinline__ int lane_asm() { int l; asm volatile("v_mbcnt_lo_u32_b32 %0, -1, 0\n\tv_mbcnt_hi_u32_b32 %0, -1, %0" : "=v"(l)); return l; }
__device__ __forceinline__ float wave_sum(float v) {
#pragma unroll
    for (int o = 1; o < 64; o <<= 1) v += __shfl_xor(v, o);
    return v; }
__device__ __forceinline__ const float* xrow_ptr(const float* xp, const float* xs, const float* meta, int r) {
    if (r < NMETA) return meta + (size_t)r * D;
    if (r < TP) return xp + (size_t)(r - NMETA) * D;
    if (r < MREAL) return xs + (size_t)(r - TP) * D;
    return nullptr; }

namespace pg8 {
constexpr int BM = 256, BK = 64, HALF = 128, HTB = HALF * BK * 2, STAGE_BYTES = 8 * HTB, NXCD = 8, WGM = 8;
__host__ __device__ __forceinline__ int lds_byte(int r, int c) { const int st = (r >> 4) * 2 + (c >> 5), rr = r & 15, cc = c & 31, ob = rr * 64 + cc * 2; return st * 1024 + (ob ^ (((ob >> 9) & 1) << 5)); }
__host__ __device__ __forceinline__ void stage_rc(int b, int& R, int& C) { const int st = b / 1024, sb = b % 1024, swz = sb ^ (((sb >> 9) & 1) << 5); R = (st >> 1) * 16 + swz / 64; C = (st & 1) * 32 + (swz % 64) / 2; }
__host__ __device__ __forceinline__ int perm32(int rho) { const int n = rho >> 4, i = rho & 15; return 8 * (i >> 2) + 4 * n + (i & 3); }
struct Unit { int pm, pn; };
struct Gemm { const bf16_t* A; const bf16_t* Bt; int M, N, K; };
struct StaticOrder {
    int nM, nN, nwg, G, c;
    __host__ __device__ void init(int M, int N, int G_, int c_) { nM = M / BM; nN = N / BM; nwg = nM * nN; G = G_; c = c_; }
    __host__ __device__ bool next(int i, Unit& u) const {
        const long L = (long)i * G + c; if (L >= nwg) return false;
        int wgid = (int)L; { const int q = nwg / NXCD, r = nwg % NXCD, xcd = wgid % NXCD, off = wgid / NXCD; wgid = (xcd < r ? xcd * (q + 1) : r * (q + 1) + (xcd - r) * q) + off; }
        const int nig = WGM * nN, gid = wgid / nig, fm = gid * WGM, gsz = (nM - fm) < WGM ? (nM - fm) : WGM;
        u.pm = fm + ((wgid % nig) % gsz); u.pn = (wgid % nig) / gsz; return true;
    }
};
__device__ __forceinline__ unsigned cvt_pk_bf16(float lo, float hi) { unsigned r; asm volatile("v_cvt_pk_bf16_f32 %0, %1, %2" : "=v"(r) : "v"(lo), "v"(hi)); return r; }

struct EpiBf16 {
    static constexpr bool PERM = true;
    bf16_t* O; int ldc;
    __device__ __forceinline__ void operator()(f32x4 (&acc)[2][2][4][2], const Unit& u, int wr, int wc, int fr, int fq) const {
        const int row0 = u.pm * BM + wr * 64 + fr, col0 = u.pn * BM + wc * 32 + 8 * fq;
#pragma unroll
        for (int ai = 0; ai < 2; ++ai)
#pragma unroll
            for (int m = 0; m < 4; ++m) { bf16_t* rowp = O + (size_t)(row0 + ai * HALF + m * 16) * ldc + col0;
#pragma unroll
                for (int bj = 0; bj < 2; ++bj) { const f32x4 v0 = acc[ai][bj][m][0], v1 = acc[ai][bj][m][1];
                    u32x4 w; w.x = cvt_pk_bf16(v0[0], v0[1]); w.y = cvt_pk_bf16(v0[2], v0[3]); w.z = cvt_pk_bf16(v1[0], v1[1]); w.w = cvt_pk_bf16(v1[2], v1[3]);
                    *(u32x4*)(rowp + bj * HALF) = w; } }
    }
};
template <bool FROM_X> struct EpiResid {
    static constexpr bool PERM = true;
    const float *xp, *xs, *meta;
    float* X;
    bf16_t* XB;
    float* SS;
    LAS float* red;
    __device__ __forceinline__ void operator()(f32x4 (&acc)[2][2][4][2], const Unit& u, int wr, int wc, int fr, int fq) const {
        const int col0 = u.pn * BM + wc * 32 + 8 * fq;
#pragma unroll
        for (int ai = 0; ai < 2; ++ai)
#pragma unroll
            for (int m = 0; m < 4; ++m) {
                const int row = u.pm * BM + ai * HALF + wr * 64 + m * 16 + fr;
                const float* br = FROM_X ? xrow_ptr(xp, xs, meta, row) : (X + (size_t)row * D);
                float ss = 0.f;
#pragma unroll
                for (int bj = 0; bj < 2; ++bj) {
                    f32x4 b0 = (f32x4){0.f, 0.f, 0.f, 0.f}, b1 = b0;
                    if (br) { b0 = *(const f32x4*)(br + col0 + bj * HALF); b1 = *(const f32x4*)(br + col0 + bj * HALF + 4); }
                    const f32x4 v0 = acc[ai][bj][m][0] + b0, v1 = acc[ai][bj][m][1] + b1;
                    float* o = X + (size_t)row * D + col0 + bj * HALF;
                    *(f32x4*)o = v0; *(f32x4*)(o + 4) = v1;
                    if (XB) { u32x4 w; w.x = cvt_pk_bf16(v0[0], v0[1]); w.y = cvt_pk_bf16(v0[2], v0[3]); w.z = cvt_pk_bf16(v1[0], v1[1]); w.w = cvt_pk_bf16(v1[2], v1[3]);
                        *(u32x4*)(XB + (size_t)row * D + col0 + bj * HALF) = w; }
                    ss += (v0[0] * v0[0] + v0[1] * v0[1]) + (v0[2] * v0[2] + v0[3] * v0[3]) + (v1[0] * v1[0] + v1[1] * v1[1]) + (v1[2] * v1[2] + v1[3] * v1[3]);
                }
                ss += __shfl_xor(ss, 16); ss += __shfl_xor(ss, 32);
                if (fq == 0) red[(ai * HALF + wr * 64 + m * 16 + fr) * 4 + wc] = ss;
            }
        asm volatile("s_waitcnt lgkmcnt(0)" ::: "memory"); __builtin_amdgcn_s_barrier(); asm volatile("" ::: "memory");
        const int t = (wr * 4 + wc) * 64 + fq * 16 + fr;
        if (t < BM) { const f32x4 v = *(const LAS f32x4*)(red + t * 4); SS[(size_t)(u.pm * BM + t) * 4 + u.pn] = (v[0] + v[1]) + (v[2] + v[3]); }
    }
};
struct EpiUpGate {
    static constexpr bool PERM = true;
    const float* SS1; const float* cw; const float* cb;
    bf16_t* ACT; float *HEAD, *TAIL, *HEADX, *TAILX;
    LAS float* bnd;
    __device__ __forceinline__ void operator()(f32x4 (&acc)[2][2][4][2], const Unit& u, int wr, int wc, int fr, int fq) const {
        const unsigned lcol = wc * 32 + 8 * fq, jc = u.pn * 128 + lcol;
        const unsigned row0 = u.pm * BM + wr * 64 + fr;
#pragma unroll
        for (int ai = 0; ai < 2; ++ai)
#pragma unroll
            for (int m = 0; m < 4; ++m) {
                const f32x4 s = gld<f32x4>(SS1, (row0 + 128u * ai + 16u * m) * 16u);
                const float rs = __builtin_amdgcn_rsqf(((s[0] + s[1]) + (s[2] + s[3])) * (1.0f / D) + EPS);
#pragma unroll
                for (int bj = 0; bj < 2; ++bj)
#pragma unroll
                    for (int n = 0; n < 2; ++n) acc[ai][bj][m][n] = acc[ai][bj][m][n] * rs;
            }
        const unsigned co = jc * 4u;
        if (fr >= 14) {
#pragma unroll
            for (int ai = 0; ai < 2; ++ai)
#pragma unroll
                for (int bj = 0; bj < 2; ++bj)
#pragma unroll
                    for (int n = 0; n < 2; ++n) *(LAS f32x4*)(bnd + ((((2 * ai + wr) * 2 + (fr - 14)) * 2 + bj) * 128 + lcol + 4 * n)) = acc[ai][bj][3][n];
            if (wr == 1) {
                const unsigned to = (unsigned)(u.pm * 2 + (fr - 14)) * (DUP * 4u) + co;
#pragma unroll
                for (int bj = 0; bj < 2; ++bj)
#pragma unroll
                    for (int n = 0; n < 2; ++n) gst<f32x4>(TAIL, to + bj * (DFF * 4u) + 16u * n) = acc[1][bj][3][n];
            }
        }
        if (wr == 0 && fr < 2) {
            const unsigned ho = (unsigned)(u.pm * 2 + fr) * (DUP * 4u) + co;
#pragma unroll
            for (int bj = 0; bj < 2; ++bj)
#pragma unroll
                for (int n = 0; n < 2; ++n) gst<f32x4>(HEAD, ho + bj * (DFF * 4u) + 16u * n) = acc[0][bj][0][n];
        }
        if (u.pm == 64 && (fr < 2 || fr >= 14)) {
            float* dst = fr < 2 ? HEADX : TAILX; const unsigned rr = fr < 2 ? fr : fr - 14;
            const unsigned xo = ((unsigned)(8 * wr) + rr) * (DUP * 4u) + co;
#pragma unroll
            for (int ai = 0; ai < 2; ++ai)
#pragma unroll
                for (int m = 0; m < 4; ++m)
#pragma unroll
                    for (int bj = 0; bj < 2; ++bj)
#pragma unroll
                        for (int n = 0; n < 2; ++n) gst<f32x4>(dst, xo + (unsigned)(16 * ai + 2 * m) * (DUP * 4u) + bj * (DFF * 4u) + 16u * n) = acc[ai][bj][m][n];
        }
        asm volatile("s_waitcnt lgkmcnt(0)" ::: "memory"); __builtin_amdgcn_s_barrier(); asm volatile("" ::: "memory");
        const unsigned ao = row0 * (DFF * 2u) + jc * 2u;
#pragma unroll
        for (int n = 0; n < 2; ++n) {
            f32x4 w0[2], w1[2], w2[2], bb[2];
#pragma unroll
            for (int bj = 0; bj < 2; ++bj) { const unsigned c = co + bj * (DFF * 4u) + 16u * n;
                w0[bj] = gld<f32x4>(cw, c); w1[bj] = gld<f32x4>(cw, c + DUP * 4u); w2[bj] = gld<f32x4>(cw, c + 2u * DUP * 4u); bb[bj] = gld<f32x4>(cb, c); }
#pragma unroll
            for (int ai = 0; ai < 2; ++ai) {
                f32x4 pg[2];
                const int slotp = 2 * ai + wr - 1;
#pragma unroll
                for (int bj = 0; bj < 2; ++bj) pg[bj] = slotp >= 0 ? *(const LAS f32x4*)(bnd + (((slotp * 2 + (fr & 1)) * 2 + bj) * 128 + lcol + 4 * n)) : (f32x4){0.f, 0.f, 0.f, 0.f};
#pragma unroll
                for (int m = 0; m < 4; ++m) {
                    float pre[2][4];
#pragma unroll
                    for (int bj = 0; bj < 2; ++bj)
#pragma unroll
                        for (int i = 0; i < 4; ++i) {
                            const float cur = acc[ai][bj][m][n][i], pv = pg[bj][i];
                            const float p1 = dppf<DPP_SHR(1)>(dppf<DPP_ROR(1)>(0.f, pv), cur);
                            const float p2 = dppf<DPP_SHR(2)>(dppf<DPP_ROR(2)>(0.f, pv), cur);
                            pre[bj][i] = bb[bj][i] + w2[bj][i] * cur + w1[bj][i] * p1 + w0[bj][i] * p2;
                        }
                    u32x2 w;
                    w.x = cvt_pk_bf16(gelu_tanh(pre[0][0]) * pre[1][0], gelu_tanh(pre[0][1]) * pre[1][1]);
                    w.y = cvt_pk_bf16(gelu_tanh(pre[0][2]) * pre[1][2], gelu_tanh(pre[0][3]) * pre[1][3]);
                    gst<u32x2>(ACT, ao + (unsigned)(128 * ai + 16 * m) * (DFF * 2u) + 8u * n) = w;
#pragma unroll
                    for (int bj = 0; bj < 2; ++bj) pg[bj] = acc[ai][bj][m][n];
                }
            }
        }
    }
};

template <class Epi>
__device__ __forceinline__ void gemm_phase(LAS unsigned char* lds, const Gemm g, const StaticOrder& S, const Epi& E, const int wid) {
    const int lane = lane_asm(), tid = wid * 64 + lane, wr = wid >> 2, wc = wid & 3, fr = lane & 15, fq = lane >> 4;
    const int K = g.K, nt = K / BK;
    unsigned voffA[2], voffB[2];
#pragma unroll
    for (int i = 0; i < 2; ++i) { int R, C; stage_rc(tid * 16 + i * 8192, R, C); const int Rb = Epi::PERM ? ((R & ~31) + perm32(R & 31)) : R;
        voffA[i] = (unsigned)(R * K + C) * 2u; voffB[i] = (unsigned)(Rb * K + C) * 2u; }
    const size_t kstep = (size_t)(BK * 2);
    const size_t hstep = (size_t)HALF * K * 2;
    const size_t tstep = 2 * hstep;
    const unsigned ldsw = (unsigned)wid * 1024u;
    const int aoff = lds_byte(wr * 64 + fr, fq * 8), boff = lds_byte(wc * 32 + fr, fq * 8);
#define PG8_SA(b, h) (((b) * 2 + (h)) * HTB)
#define PG8_SB(b, h) ((4 + (b) * 2 + (h)) * HTB)
#define PG8_STAGE(bufoff, gbase, voff) do { _Pragma("unroll") for (int _i = 0; _i < 2; ++_i) \
        __builtin_amdgcn_global_load_lds((const unsigned*)((const char*)(gbase) + (voff)[_i]), (LAS unsigned*)(lds + (bufoff) + ldsw + _i * 8192), 16, 0, 0); } while (0)
#define PG8_LDA(dst, b, h) do { _Pragma("unroll") for (int m = 0; m < 4; ++m) _Pragma("unroll") for (int k = 0; k < 2; ++k) dst[m][k] = *(const LAS bf16x8*)(lds + PG8_SA(b, h) + aoff + m * 2048 + k * 1024); } while (0)
#define PG8_LDB(dst, b, h) do { _Pragma("unroll") for (int n = 0; n < 2; ++n) _Pragma("unroll") for (int k = 0; k < 2; ++k) dst[n][k] = *(const LAS bf16x8*)(lds + PG8_SB(b, h) + boff + n * 2048 + k * 1024); } while (0)
#define PG8_MMA(ai, bj, At, Bt) do { __builtin_amdgcn_s_setprio(1); _Pragma("unroll") for (int m = 0; m < 4; ++m) _Pragma("unroll") for (int n = 0; n < 2; ++n) _Pragma("unroll") for (int k = 0; k < 2; ++k) \
        acc[ai][bj][m][n] = __builtin_amdgcn_mfma_f32_16x16x32_bf16(Bt[n][k], At[m][k], acc[ai][bj][m][n], 0, 0, 0); __builtin_amdgcn_s_setprio(0); } while (0)
#define PG8_WAIT_V(n) asm volatile("s_waitcnt vmcnt(" #n ")" ::: "memory")
#define PG8_WAIT_L(n) asm volatile("s_waitcnt lgkmcnt(" #n ")" ::: "memory")
#define PG8_BAR __builtin_amdgcn_s_barrier()
#define PG8_SCHED __builtin_amdgcn_sched_barrier(0)
    Unit cur, nxt; int ui = 0;
    if (!S.next(0, cur)) return;
    f32x4 acc[2][2][4][2];
#pragma unroll
    for (int a = 0; a < 2; ++a)
#pragma unroll
        for (int b = 0; b < 2; ++b)
#pragma unroll
            for (int m = 0; m < 4; ++m)
#pragma unroll
                for (int n = 0; n < 2; ++n) acc[a][b][m][n] = (f32x4){0.f, 0.f, 0.f, 0.f};
    bf16x8 At[4][2], B0[2][2], B1[2][2];
    const char* cA = (const char*)g.A + (size_t)cur.pm * tstep; const char* cB = (const char*)g.Bt + (size_t)cur.pn * tstep;
    PG8_STAGE(PG8_SB(0, 0), cB, voffB); PG8_STAGE(PG8_SB(0, 1), cB + hstep, voffB); PG8_STAGE(PG8_SA(0, 0), cA, voffA); PG8_STAGE(PG8_SA(0, 1), cA + hstep, voffA);
    if (wr == 1) PG8_BAR;
    PG8_WAIT_V(2); PG8_BAR;
    PG8_STAGE(PG8_SB(1, 0), cB + kstep, voffB); PG8_STAGE(PG8_SA(1, 0), cA + kstep, voffA); PG8_STAGE(PG8_SB(1, 1), cB + hstep + kstep, voffB);
    PG8_WAIT_V(6); PG8_BAR;
    for (;;) {
        const bool has_next = S.next(ui + 1, nxt);
        const char* nA = has_next ? (const char*)g.A + (size_t)nxt.pm * tstep : cA; const char* nB = has_next ? (const char*)g.Bt + (size_t)nxt.pn * tstep : cB;
        for (int t = 0; t < nt; t += 2) {
            const bool last = (t == nt - 2);
            const char* a1 = cA + (size_t)(t + 1) * kstep;
            const char* a2 = last ? nA : cA + (size_t)(t + 2) * kstep; const char* b2 = last ? nB : cB + (size_t)(t + 2) * kstep;
            const char* a3 = a2 + kstep; const char* b3 = b2 + kstep;
            PG8_LDB(B0, 0, 0); PG8_LDB(B1, 0, 1); PG8_SCHED; PG8_LDA(At, 0, 0); PG8_STAGE(PG8_SA(1, 1), a1 + hstep, voffA);
            PG8_WAIT_V(8); PG8_WAIT_L(0); PG8_BAR; PG8_MMA(0, 0, At, B0); PG8_MMA(0, 1, At, B1); PG8_BAR; PG8_SCHED;
            PG8_LDA(At, 0, 1); PG8_STAGE(PG8_SB(0, 0), b2, voffB); PG8_STAGE(PG8_SB(0, 1), b2 + hstep, voffB); PG8_STAGE(PG8_SA(0, 0), a2, voffA);
            PG8_WAIT_V(8); PG8_WAIT_L(0); PG8_BAR; PG8_MMA(1, 0, At, B0); PG8_MMA(1, 1, At, B1); PG8_BAR; PG8_SCHED;
            PG8_LDB(B0, 1, 0); PG8_LDB(B1, 1, 1); PG8_SCHED; PG8_LDA(At, 1, 0); PG8_STAGE(PG8_SA(0, 1), a2 + hstep, voffA);
            PG8_WAIT_V(8); PG8_WAIT_L(0); PG8_BAR; PG8_MMA(0, 0, At, B0); PG8_MMA(0, 1, At, B1); PG8_BAR; PG8_SCHED;
            PG8_LDA(At, 1, 1); PG8_STAGE(PG8_SB(1, 0), b3, voffB); PG8_STAGE(PG8_SB(1, 1), b3 + hstep, voffB); PG8_STAGE(PG8_SA(1, 0), a3, voffA);
            PG8_WAIT_V(8); PG8_WAIT_L(0); PG8_BAR; PG8_MMA(1, 0, At, B0); PG8_MMA(1, 1, At, B1); PG8_BAR; PG8_SCHED;
        }
        if (wr == 0) PG8_BAR;
        E(acc, cur, wr, wc, fr, fq);
        if (!has_next) break;
#pragma unroll
        for (int a = 0; a < 2; ++a)
#pragma unroll
            for (int b = 0; b < 2; ++b)
#pragma unroll
                for (int m = 0; m < 4; ++m)
#pragma unroll
                    for (int n = 0; n < 2; ++n) acc[a][b][m][n] = (f32x4){0.f, 0.f, 0.f, 0.f};
        cur = nxt; cA = nA; cB = nB; ++ui;
        if (wr == 1) PG8_BAR;
    }
    PG8_WAIT_V(0);
    PG8_BAR;
#undef PG8_SA
#undef PG8_SB
#undef PG8_STAGE
#undef PG8_LDA
#undef PG8_LDB
#undef PG8_MMA
#undef PG8_WAIT_V
#undef PG8_WAIT_L
#undef PG8_BAR
#undef PG8_SCHED
}
}

constexpr int NWAVES = 8;
constexpr int N_LAUNCHES = MK_N_LAUNCHES;
constexpr int RING_BYTES = 131072, LDSCTL_OFF = RING_BYTES, MISC_OFF = LDSCTL_OFF + 320, BND_OFF = RING_BYTES + 1024, LDS_BYTES = 147456;
static_assert(BND_OFF + 8192 <= LDS_BYTES, "LDS map");

typedef GAS unsigned gu32;
#define XB_TMO      128
#define XB_XCNT(j)  (256  + 64 * (j))
#define XB_XSUB(j)  (1280 + 64 * (j))
#define XB_XGEN(j)  (2304 + 64 * (j))
#define XB_TOP      3328
#define XB_TOPGEN   3392
#define XCD_BAR_WORDS 3456
#define XB_SPIN_CAP (1u << 18)
__device__ __forceinline__ unsigned xb_ld(unsigned* p)              { return __hip_atomic_load(p, __ATOMIC_RELAXED, __HIP_MEMORY_SCOPE_AGENT); }
__device__ __forceinline__ unsigned xb_add(unsigned* p, unsigned v) { return __hip_atomic_fetch_add(p, v, __ATOMIC_RELAXED, __HIP_MEMORY_SCOPE_AGENT); }
__device__ __forceinline__ unsigned xb_xcc_id() { return (unsigned)__builtin_amdgcn_s_getreg((3 << 11) | 20) & 0xFu; }
#define XB_SPIN(cond, bar) do { unsigned _sp = 0; while (cond) { __builtin_amdgcn_s_sleep(1); \
    if ((++_sp & 255u) == 0u) { if (xb_ld(&(bar)[XB_TMO])) break; if (_sp > XB_SPIN_CAP) { atomicAdd(&(bar)[XB_TMO], 1u); break; } } } } while (0)
struct XcdBarrier { unsigned* bar; unsigned x; volatile LAS unsigned* st; };
__device__ __forceinline__ XcdBarrier xcd_barrier_post(unsigned* bar, volatile LAS unsigned* st, bool leader) {
    XcdBarrier b; b.bar = bar; b.x = xb_xcc_id(); b.st = st;
    if (leader) (void)xb_add(&bar[XB_XCNT(b.x)], 1u);
    return b;
}
__device__ __forceinline__ void xcd_barrier_complete(unsigned* bar, unsigned x, unsigned& nloc, unsigned& nx) {
    const unsigned G = gridDim.x * gridDim.y * gridDim.z;
    unsigned sum, cnt, mine, sp = 0u;
    for (;;) {
        sum = 0u; cnt = 0u; mine = 0u;
#pragma unroll
        for (unsigned j = 0; j < 16; ++j) { const unsigned c = xb_ld(&bar[XB_XCNT(j)]); sum += c; cnt += (c > 0u) ? 1u : 0u; mine = (j == x) ? c : mine; }
        if (sum == G) break;
        __builtin_amdgcn_s_sleep(1);
        if ((++sp & 255u) == 0u) { if (xb_ld(&bar[XB_TMO])) break; if (sp > XB_SPIN_CAP) { atomicAdd(&bar[XB_TMO], 1u); break; } }
    }
    nloc = mine > 0u ? mine : 1u; nx = cnt > 0u ? cnt : 1u;
}
__device__ __forceinline__ void xcd_barrier(const XcdBarrier& b, int wave) {
    asm volatile("s_waitcnt vmcnt(0)" ::: "memory");
    __syncthreads();
    if (wave == 0 && lane_asm() == 0) {
        unsigned* bar = b.bar;
        __builtin_amdgcn_s_waitcnt(0);
        unsigned nloc = b.st[0], nx = b.st[1];
        if (nloc == 0u) { xcd_barrier_complete(bar, b.x, nloc, nx); b.st[0] = nloc; b.st[1] = nx; }
        const unsigned old = xb_add(&bar[XB_XSUB(b.x)], 1u);
        const unsigned gen = old / nloc;
        if (old + 1u == (gen + 1u) * nloc) {
            __builtin_amdgcn_fence(__ATOMIC_RELEASE, "agent");
            asm volatile("s_waitcnt vmcnt(0)" ::: "memory");
            const unsigned og = xb_add(&bar[XB_TOP], 1u);
            const unsigned tg = og / nx;
            if (og + 1u == (tg + 1u) * nx) xb_add(&bar[XB_TOPGEN], 1u);
            else XB_SPIN(xb_ld(&bar[XB_TOPGEN]) == tg, bar);
            __builtin_amdgcn_fence(__ATOMIC_ACQUIRE, "agent");
            xb_add(&bar[XB_XGEN(b.x)], 1u);
            asm volatile("s_waitcnt vmcnt(0)" ::: "memory");
        } else {
            XB_SPIN(xb_ld(&bar[XB_XGEN(b.x)]) == gen, bar);
            __builtin_amdgcn_fence(__ATOMIC_ACQUIRE, "agent");
            asm volatile("s_waitcnt vmcnt(0)" ::: "memory");
        }
    }
    __syncthreads();
}

struct Args { const float* in[28]; float* out; unsigned char* ws; int ph_lo, ph_hi, li, pad; };
struct Frame {
    LAS unsigned char* lds; int wave, G, gw, NGW;
    const float* const* in; float* out; unsigned char* ws;
};
enum { I_XP = 0, I_XS, I_SLH, I_SLC, I_SPOOL, I_SFFN, I_META, I_GMIX, I_WIN, I_CLW, I_CLB, I_GAW, I_GAB, I_GXW, I_GXB, I_LAM, I_PW, I_PB, I_PS, I_GNL, I_GNP,
       I_WOUT, I_GFFN, I_WUP, I_FCW, I_FCB, I_WDN, I_GFIN };

__device__ __forceinline__ void p0_tr_item(const float* W, int ldw, int src_col0, int k0, bf16_t* WT, int ldt, int dst_row0, const float* kscale, LAS float* scr, int lane) {
#pragma unroll 8
    for (int i = 0; i < 32; ++i) { const int kk = 2 * i + (lane >> 5); const float sc = kscale ? kscale[k0 + kk] : 1.0f;
        scr[kk * 33 + (lane & 31)] = W[(size_t)(k0 + kk) * ldw + src_col0 + (lane & 31)] * sc; }
    LDS_WAIT(); asm volatile("" ::: "memory");
    const int c = lane & 7;
#pragma unroll
    for (int j = 0; j < 4; ++j) { const int n = (lane >> 3) + 8 * j; const LAS float* s = scr + (8 * c) * 33 + n;
        u32x4 o; o.x = pk2(s[0 * 33], s[1 * 33]); o.y = pk2(s[2 * 33], s[3 * 33]); o.z = pk2(s[4 * 33], s[5 * 33]); o.w = pk2(s[6 * 33], s[7 * 33]);
        *(u32x4*)(WT + (size_t)(dst_row0 + n) * ldt + k0 + 8 * c) = o; }
    LDS_WAIT(); asm volatile("" ::: "memory");
}
__device__ __forceinline__ void p0_prologue(Frame& F) {
    const int lane = lane_asm();
    LAS float* scr = (LAS float*)(F.lds + F.wave * 16384);
    unsigned char* ws = F.ws;
    bf16_t* WIN = (bf16_t*)(ws + WS_WIN); bf16_t* WOUT = (bf16_t*)(ws + WS_WOUT); bf16_t* WUP = (bf16_t*)(ws + WS_WUP); bf16_t* WDN = (bf16_t*)(ws + WS_WDN);
    bf16_t* WA = (bf16_t*)(ws + WS_WA); bf16_t* WX = (bf16_t*)(ws + WS_WX); bf16_t* PW = (bf16_t*)(ws + WS_PW);
    constexpr int I_IN = (D / 64) * (DIN / 32), I_OUT = (D / 64) * (D / 32), I_UP = (D / 64) * (DUP / 32), I_DN = (DFF / 64) * (D / 32), I_GA = 8 * 2, I_PWI = 4 * 2 * 4;
    constexpr int NITEMS = I_IN + I_OUT + I_UP + I_DN + 2 * I_GA + I_PWI;
    for (int it = F.gw; it < NITEMS; it += F.NGW) {
        int r = it;
        if (r < I_IN) { const int nb = DIN / 32, kb = r / nb, n0 = 32 * (r % nb); p0_tr_item(F.in[I_WIN], DIN, n0, 64 * kb, WIN, D, n0, F.in[I_GMIX], scr, lane); continue; } r -= I_IN;
        if (r < I_OUT) { const int nb = D / 32, kb = r / nb, n0 = 32 * (r % nb); const int k0 = 64 * kb;
            p0_tr_item(F.in[I_WOUT], D, n0, k0, WOUT, D, n0, k0 < DLRU ? F.in[I_GNL] : F.in[I_GNP] - DLRU, scr, lane); continue; } r -= I_OUT;
        if (r < I_UP) { const int nb = DUP / 32, kb = r / nb, n0 = 32 * (r % nb);
            const int pn = n0 >> 8, bj = (n0 >> 7) & 1, q = n0 & 127; p0_tr_item(F.in[I_WUP], DUP, DFF * bj + 128 * pn + q, 64 * kb, WUP, D, n0, F.in[I_GFFN], scr, lane); continue; } r -= I_UP;
        if (r < I_DN) { const int nb = D / 32, kb = r / nb, n0 = 32 * (r % nb); p0_tr_item(F.in[I_WDN], D, n0, 64 * kb, WDN, DFF, n0, nullptr, scr, lane); continue; } r -= I_DN;
        if (r < I_GA) { const int h = r >> 1, n0 = 32 * (r & 1); p0_tr_item(F.in[I_GAW] + h * 4096, 64, n0, 0, WA + h * 4096, 64, n0, nullptr, scr, lane); continue; } r -= I_GA;
        if (r < I_GA) { const int h = r >> 1, n0 = 32 * (r & 1); p0_tr_item(F.in[I_GXW] + h * 4096, 64, n0, 0, WX + h * 4096, 64, n0, nullptr, scr, lane); continue; } r -= I_GA;
        { const int g = r >> 3, kb = (r >> 2) & 1, n0 = 32 * (r & 3); p0_tr_item(F.in[I_PW] + g * 16384, 128, n0, 64 * kb, PW + g * 16384, 128, n0, nullptr, scr, lane); }
    }
    bf16_t* XN0 = (bf16_t*)(ws + WS_XN0); bf16_t* Z = (bf16_t*)(ws + WS_Z);
    for (int m = F.gw; m < MPAD; m += F.NGW) {
        const float* xr = xrow_ptr(F.in[I_XP], F.in[I_XS], F.in[I_META], m);
        unsigned long long* o8 = (unsigned long long*)(XN0 + (size_t)m * D) + lane;
        if (!xr) {
#pragma unroll
            for (int j = 0; j < 4; ++j) o8[64 * j] = 0ull;
            unsigned long long* z8 = (unsigned long long*)(Z + (size_t)m * D) + lane;
#pragma unroll
            for (int j = 0; j < 4; ++j) z8[64 * j] = 0ull;
            continue; }
        const f32x4* x4 = (const f32x4*)xr + lane;
        f32x4 v[4]; float s = 0.f;
#pragma unroll
        for (int j = 0; j < 4; ++j) { v[j] = x4[64 * j]; s += (v[j].x * v[j].x + v[j].y * v[j].y) + (v[j].z * v[j].z + v[j].w * v[j].w); }
        const float rs = 1.0f / sqrtf(wave_sum(s) * (1.0f / D) + EPS);
#pragma unroll
        for (int j = 0; j < 4; ++j) o8[64 * j] = (unsigned long long)pk2(v[j].x * rs, v[j].y * rs) | ((unsigned long long)pk2(v[j].z * rs, v[j].w * rs) << 32);
    }
    bf16_t* U = (bf16_t*)(ws + WS_U);
    for (int e = F.gw * 64 + lane; e < 9 * 16 * DIN; e += F.NGW * 64) {
        const int hr = e / DIN, col = e % DIN, sid = hr >> 4, k = hr & 15; float v = 0.f;
        if (sid > 0) { const int b = sid - 1;
            if (col < DLRU) { if (k >= 13) v = F.in[I_SLC][((size_t)b * 3 + (k - 13)) * DLRU + col]; }
            else if (col >= 2 * DLRU) { if (k >= 1) v = F.in[I_SPOOL][((size_t)b * 15 + (k - 1)) * 512 + (col - 2 * DLRU)]; } }
        U[(size_t)(MPAD + hr) * DIN + col] = (bf16_t)f2bf(v);
    }
    float* LSL = (float*)(ws + WS_LSL);
    for (int e = F.gw * 64 + lane; e < DLRU; e += F.NGW * 64) { const float x = F.in[I_LAM][e]; LSL[e] = -8.0f * (fmaxf(-x, 0.f) + log1pf(expf(-fabsf(x)))); }
}

template <bool FINAL>
__device__ __forceinline__ void p2_phase(Frame& F) {
    const int lane = lane_asm(), w = F.wave, fr = lane & 15, fq = lane >> 4, tid = w * 64 + lane;
    unsigned char* ws = F.ws;
    const bf16_t* U = (const bf16_t*)(ws + WS_U);
    const bf16_t* WA = (const bf16_t*)(ws + WS_WA); const bf16_t* WX = (const bf16_t*)(ws + WS_WX); const bf16_t* PW = (const bf16_t*)(ws + WS_PW);
    const float* LSL = (const float*)(ws + WS_LSL);
    float* AGGA = (float*)(ws + WS_AGGA); float* AGGH = (float*)(ws + WS_AGGH);
    bf16_t* Z = (bf16_t*)(ws + WS_Z);
    LAS float* ssq = (LAS float*)F.lds;
    const unsigned chl = 64u * w + 8u * fq;
    const unsigned g = (unsigned)w >> 1, half = w & 1;
    const unsigned sigl = 8u * (fr >> 2) + (fr & 3);
    const unsigned wg_off = ((64u * w + sigl) * 64u + 8u * fq) * 2u;
    const unsigned pw_off = ((128u * g + 64u * half + sigl) * 128u + 8u * fq) * 2u;
    for (int item = blockIdx.x; item < NITEM2; item += F.G) {
        const bool prompt = item < NCHUNK_P;
        if (!FINAL && !prompt) continue;
        const int sb = prompt ? 0 : item - NCHUNK_P;
        const int base_row = prompt ? item * CHUNK : TP + 16 * sb, sid = prompt ? 0 : 1 + sb, ti0 = prompt ? item * CHUNK : 0, nblk = prompt ? 5 : 1;
        const int stream_base = prompt ? 0 : base_row, halo_base = MPAD + 16 * sid + 16;
        float hprev[2][8], pprev[2][8];
#pragma unroll
        for (int s = 0; s < 2; ++s)
#pragma unroll
            for (int j = 0; j < 8; ++j) { hprev[s][j] = 0.f; pprev[s][j] = 1.f; }
        float csprev[4][8];
        if (FINAL) {
            if (prompt) {
#pragma unroll 2
                for (int q = 0; q < item; ++q) {
                    const unsigned ao = ((unsigned)q * DLRU + chl) * 4u;
#pragma unroll
                    for (int s = 0; s < 2; ++s) {
                        const f32x4 a0 = gld<f32x4>(AGGA, ao + 128u * s), a1 = gld<f32x4>(AGGA, ao + 128u * s + 16u), h0 = gld<f32x4>(AGGH, ao + 128u * s), h1 = gld<f32x4>(AGGH, ao + 128u * s + 16u);
#pragma unroll
                        for (int j = 0; j < 4; ++j) { hprev[s][j] = a0[j] * hprev[s][j] + h0[j]; hprev[s][4 + j] = a1[j] * hprev[s][4 + j] + h1[j]; }
                    }
                }
            } else {
                const unsigned ho = ((unsigned)sb * DLRU + chl) * 4u;
#pragma unroll
                for (int s = 0; s < 2; ++s) { const f32x4 a0 = gld<f32x4>(F.in[I_SLH], ho + 128u * s), a1 = gld<f32x4>(F.in[I_SLH], ho + 128u * s + 16u);
#pragma unroll
                    for (int j = 0; j < 4; ++j) { hprev[s][j] = a0[j]; hprev[s][4 + j] = a1[j]; } }
            }
            const int tiw = ti0 - 16 + fr; const unsigned roww = (unsigned)(tiw >= 0 ? stream_base + tiw : halo_base + tiw);
            const unsigned uo = (roww * DIN + 2u * DLRU + 128u * g + 8u * fq) * 2u;
#pragma unroll
            for (int s = 0; s < 4; ++s) {
                float x[8]; unpack8(gld<u32x4>(U, uo + 64u * s), x);
#pragma unroll
                for (int j = 0; j < 8; ++j) { float cs = x[j];
                    cs += dppf<DPP_SHR(1)>(0.f, cs); cs += dppf<DPP_SHR(2)>(0.f, cs); cs += dppf<DPP_SHR(4)>(0.f, cs); cs += dppf<DPP_SHR(8)>(0.f, cs);
                    csprev[s][j] = cs; }
            }
        }
#pragma unroll 1
        for (int b = 0; b < nblk; ++b) {
            const int ti = ti0 + 16 * b + fr; const unsigned row = (unsigned)(base_row + 16 * b + fr);
            unsigned cho = chl * 4u;
            asm volatile("" : "+v"(cho));
            float c[2][8]; bf16x8 cbf[2];
            unsigned ur[4];
#pragma unroll
            for (int k = 0; k < 4; ++k) { const int tk = ti - 3 + k; ur[k] = ((unsigned)(tk >= 0 ? stream_base + tk : halo_base + tk) * DIN + chl) * 2u; }
#pragma unroll
            for (int s = 0; s < 2; ++s) {
                { const f32x4 b0 = gld<f32x4>(F.in[I_CLB], cho + 128u * s), b1 = gld<f32x4>(F.in[I_CLB], cho + 128u * s + 16u);
#pragma unroll
                  for (int j = 0; j < 4; ++j) { c[s][j] = b0[j]; c[s][4 + j] = b1[j]; } }
#pragma unroll
                for (int k = 0; k < 4; ++k) {
                    float x[8]; unpack8(gld<u32x4>(U, ur[k] + 64u * s), x);
                    const f32x4 w0 = gld<f32x4>(F.in[I_CLW], cho + 2048u * k + 128u * s), w1 = gld<f32x4>(F.in[I_CLW], cho + 2048u * k + 128u * s + 16u);
#pragma unroll
                    for (int j = 0; j < 4; ++j) { c[s][j] += w0[j] * x[j]; c[s][4 + j] += w1[j] * x[4 + j]; }
                }
                const u32x4 pk = pack8(c[s]); cbf[s] = __builtin_bit_cast(bf16x8, pk);
            }
            f32x4 ra[4], ia[4];
#pragma unroll
            for (int n = 0; n < 4; ++n) { ra[n] = (f32x4){0.f, 0.f, 0.f, 0.f}; ia[n] = ra[n]; }
            unsigned wgo = wg_off; asm volatile("" : "+v"(wgo));
#pragma unroll
            for (int n = 0; n < 4; ++n)
#pragma unroll
                for (int s = 0; s < 2; ++s) {
                    const unsigned o = wgo + (32u * (n >> 1) + 4u * (n & 1)) * 128u + 64u * s;
                    const bf16x8 wa = gld<bf16x8>(WA, o), wx = gld<bf16x8>(WX, o);
                    ra[n] = __builtin_amdgcn_mfma_f32_16x16x32_bf16(wa, cbf[s], ra[n], 0, 0, 0);
                    ia[n] = __builtin_amdgcn_mfma_f32_16x16x32_bf16(wx, cbf[s], ia[n], 0, 0, 0);
                }
            float av[2][8], vv[2][8];
#pragma unroll
            for (int s = 0; s < 2; ++s) {
                const f32x4 ga0 = gld<f32x4>(F.in[I_GAB], cho + 128u * s), ga1 = gld<f32x4>(F.in[I_GAB], cho + 128u * s + 16u);
                const f32x4 gx0 = gld<f32x4>(F.in[I_GXB], cho + 128u * s), gx1 = gld<f32x4>(F.in[I_GXB], cho + 128u * s + 16u);
                const f32x4 l0 = gld<f32x4>(LSL, cho + 128u * s), l1 = gld<f32x4>(LSL, cho + 128u * s + 16u);
#pragma unroll
                for (int j = 0; j < 8; ++j) {
                    const int n = 2 * s + (j >> 2), rg = j & 3;
                    const float gab = j < 4 ? ga0[j & 3] : ga1[j & 3], gxb = j < 4 ? gx0[j & 3] : gx1[j & 3], lsl = j < 4 ? l0[j & 3] : l1[j & 3];
                    const float r = fast_sigmoid(ra[n][rg] + gab), ig = fast_sigmoid(ia[n][rg] + gxb);
                    const float la = r * lsl;
                    const float a = __builtin_amdgcn_exp2f(la * 1.4426950408889634f);
                    const float x2 = la + la;
                    const float poly = -x2 * (1.f + x2 * 0.5f * (1.f + x2 * (1.f / 3.f) * (1.f + x2 * 0.25f * (1.f + x2 * 0.2f * (1.f + x2 * (1.f / 6.f))))));
                    const float om = x2 > -0.25f ? poly : 1.0f - a * a;
                    av[s][j] = a; vv[s][j] = __builtin_amdgcn_sqrtf(om) * (ig * c[s][j]);
                }
            }
#pragma unroll
            for (int s = 0; s < 2; ++s)
#pragma unroll
                for (int j = 0; j < 8; ++j) {
                    float a = av[s][j], v = vv[s][j];
                    const float ph = dppf<DPP_ROR(1)>(0.f, hprev[s][j]);
                    if (!FINAL) { const float pp = dppf<DPP_ROR(1)>(0.f, pprev[s][j]); if (fr == 0) { v = a * ph + v; a = a * pp; } }
                    else { if (fr == 0) v = a * ph + v; }
                    { const float vp = dppf<DPP_SHR(1)>(0.f, v), ap = dppf<DPP_SHR(1)>(1.f, a); v = a * vp + v; a = a * ap; }
                    { const float vp = dppf<DPP_SHR(2)>(0.f, v), ap = dppf<DPP_SHR(2)>(1.f, a); v = a * vp + v; a = a * ap; }
                    { const float vp = dppf<DPP_SHR(4)>(0.f, v), ap = dppf<DPP_SHR(4)>(1.f, a); v = a * vp + v; a = a * ap; }
                    { const float vp = dppf<DPP_SHR(8)>(0.f, v), ap = dppf<DPP_SHR(8)>(1.f, a); v = a * vp + v; a = a * ap; }
                    hprev[s][j] = v; pprev[s][j] = a;
                }
            if (!FINAL) continue;
            float yl[2][8]; float ssl = 0.f;
            const unsigned urow = row * (DIN * 2u);
#pragma unroll
            for (int s = 0; s < 2; ++s) {
                float gx[8]; unpack8(gld<u32x4>(U, urow + (DLRU + chl) * 2u + 64u * s), gx);
#pragma unroll
                for (int j = 0; j < 8; ++j) { yl[s][j] = hprev[s][j] * gelu_tanh(gx[j]); ssl += yl[s][j] * yl[s][j]; }
            }
            ssl += __shfl_xor(ssl, 16); ssl += __shfl_xor(ssl, 32);
            bf16x8 mb[4];
            { const int pos = prompt ? ti : 1024 + ti; const int wl = 2 << g; const float invc = 1.0f / (float)(pos + 1 < wl ? pos + 1 : wl);
#pragma unroll
              for (int s = 0; s < 4; ++s) {
                float x[8], m8[8]; unpack8(gld<u32x4>(U, urow + (2u * DLRU + 128u * g + 8u * fq) * 2u + 64u * s), x);
#pragma unroll
                for (int j = 0; j < 8; ++j) {
                    const float cp = csprev[s][j];
                    float cs = x[j]; const float t0 = dppf<DPP_ROR(1)>(0.f, cp); if (fr == 0) cs += t0;
                    cs += dppf<DPP_SHR(1)>(0.f, cs); cs += dppf<DPP_SHR(2)>(0.f, cs); cs += dppf<DPP_SHR(4)>(0.f, cs); cs += dppf<DPP_SHR(8)>(0.f, cs);
                    float sh;
                    if (g == 0) sh = dppf<DPP_SHR(2)>(dppf<DPP_ROR(2)>(0.f, cp), cs);
                    else if (g == 1) sh = dppf<DPP_SHR(4)>(dppf<DPP_ROR(4)>(0.f, cp), cs);
                    else if (g == 2) sh = dppf<DPP_SHR(8)>(dppf<DPP_ROR(8)>(0.f, cp), cs);
                    else sh = cp;
                    m8[j] = (cs - sh) * invc - x[j];
                    csprev[s][j] = cs;
                }
                const u32x4 pk = pack8(m8); mb[s] = __builtin_bit_cast(bf16x8, pk);
              } }
            f32x4 pacc[4];
#pragma unroll
            for (int n = 0; n < 4; ++n) pacc[n] = (f32x4){0.f, 0.f, 0.f, 0.f};
            unsigned pwo = pw_off; asm volatile("" : "+v"(pwo));
#pragma unroll
            for (int n = 0; n < 4; ++n)
#pragma unroll
                for (int s = 0; s < 4; ++s) {
                    const bf16x8 pw = gld<bf16x8>(PW, pwo + (32u * (n >> 1) + 4u * (n & 1)) * 256u + 64u * s);
                    pacc[n] = __builtin_amdgcn_mfma_f32_16x16x32_bf16(pw, mb[s], pacc[n], 0, 0, 0);
                }
            float yp[2][8]; float ssp = 0.f;
            unsigned dco = (128u * g + 64u * half + 8u * fq) * 4u; asm volatile("" : "+v"(dco));
#pragma unroll
            for (int p = 0; p < 2; ++p) {
                const f32x4 b0 = gld<f32x4>(F.in[I_PB], dco + 128u * p), b1 = gld<f32x4>(F.in[I_PB], dco + 128u * p + 16u);
                const f32x4 s0 = gld<f32x4>(F.in[I_PS], dco + 128u * p), s1 = gld<f32x4>(F.in[I_PS], dco + 128u * p + 16u);
#pragma unroll
                for (int j = 0; j < 8; ++j) { const int n = 2 * p + (j >> 2), rg = j & 3;
                    const float bbv = j < 4 ? b0[j & 3] : b1[j & 3], scv = j < 4 ? s0[j & 3] : s1[j & 3];
                    yp[p][j] = (pacc[n][rg] + bbv) * scv; ssp += yp[p][j] * yp[p][j]; }
            }
            ssp += __shfl_xor(ssp, 16); ssp += __shfl_xor(ssp, 32);
            const int par = b & 1;
            if (fq == 0) { ssq[((par * 2 + 0) * 16 + fr) * 8 + w] = ssl; ssq[((par * 2 + 1) * 16 + fr) * 8 + w] = ssp; }
            asm volatile("s_waitcnt lgkmcnt(0)" ::: "memory"); __builtin_amdgcn_s_barrier(); asm volatile("" ::: "memory");
            float rsl, rsp;
            { const LAS f32x4* q = (const LAS f32x4*)(ssq + ((par * 2 + 0) * 16 + fr) * 8); const f32x4 a0 = q[0], a1 = q[1];
              rsl = __builtin_amdgcn_rsqf((((a0[0] + a0[1]) + (a0[2] + a0[3])) + ((a1[0] + a1[1]) + (a1[2] + a1[3]))) * (1.0f / 512.f) + EPS); }
            { const LAS f32x4* q = (const LAS f32x4*)(ssq + ((par * 2 + 1) * 16 + fr) * 8); const f32x4 a0 = q[0], a1 = q[1];
              rsp = __builtin_amdgcn_rsqf((((a0[0] + a0[1]) + (a0[2] + a0[3])) + ((a1[0] + a1[1]) + (a1[2] + a1[3]))) * (1.0f / 512.f) + EPS); }
            const unsigned zrow = row * (D * 2u);
#pragma unroll
            for (int s = 0; s < 2; ++s) { float o[8];
#pragma unroll
                for (int j = 0; j < 8; ++j) o[j] = yl[s][j] * rsl;
                gst<u32x4>(Z, zrow + chl * 2u + 64u * s) = pack8(o); }
#pragma unroll
            for (int p = 0; p < 2; ++p) { float o[8];
#pragma unroll
                for (int j = 0; j < 8; ++j) o[j] = yp[p][j] * rsp;
                gst<u32x4>(Z, zrow + (DLRU + 128u * g + 64u * half + 8u * fq) * 2u + 64u * p) = pack8(o); }
        }
        if (!FINAL) {
            if (fr == 15) {
                const unsigned ao = ((unsigned)item * DLRU + chl) * 4u;
#pragma unroll
                for (int s = 0; s < 2; ++s) {
                    gst<f32x4>(AGGA, ao + 128u * s) = (f32x4){pprev[s][0], pprev[s][1], pprev[s][2], pprev[s][3]}; gst<f32x4>(AGGA, ao + 128u * s + 16u) = (f32x4){pprev[s][4], pprev[s][5], pprev[s][6], pprev[s][7]};
                    gst<f32x4>(AGGH, ao + 128u * s) = (f32x4){hprev[s][0], hprev[s][1], hprev[s][2], hprev[s][3]}; gst<f32x4>(AGGH, ao + 128u * s + 16u) = (f32x4){hprev[s][4], hprev[s][5], hprev[s][6], hprev[s][7]};
                }
            }
        } else {
            const bool lastp = (item == NCHUNK_P - 1);
            if (lastp || !prompt) {
                float* oh = F.out + (lastp ? O_PH : O_SH + (size_t)sb * DLRU);
                if (fr == 15) {
#pragma unroll
                    for (int s = 0; s < 2; ++s) { float* p = oh + chl + 32 * s;
                        *(f32x4*)p = (f32x4){hprev[s][0], hprev[s][1], hprev[s][2], hprev[s][3]}; *(f32x4*)(p + 4) = (f32x4){hprev[s][4], hprev[s][5], hprev[s][6], hprev[s][7]}; }
                }
                const int last_row = lastp ? TP - 1 : base_row + 15;
                float* oc = F.out + (lastp ? O_PC : O_SC + (size_t)sb * 3 * DLRU);
                float* op = F.out + (lastp ? O_PP : O_SP + (size_t)sb * 15 * 512);
                for (int e = tid; e < 3 * DLRU; e += NWAVES * 64) { const int k = e / DLRU, ch = e % DLRU; oc[e] = bflo((unsigned)U[(size_t)(last_row - 2 + k) * DIN + ch]); }
                for (int e = tid; e < 15 * 512; e += NWAVES * 64) { const int k = e / 512, ch = e % 512; op[e] = bflo((unsigned)U[(size_t)(last_row - 14 + k) * DIN + 2 * DLRU + ch]); }
            }
        }
    }
}

__device__ __forceinline__ void p6_fixup(Frame& F) {
    const int lane = lane_asm();
    unsigned char* ws = F.ws;
    const float* HEAD = (const float*)(ws + WS_HEAD); const float* TAIL = (const float*)(ws + WS_TAIL); const float* HEADX = (const float*)(ws + WS_HEADX); const float* TAILX = (const float*)(ws + WS_TAILX);
    bf16_t* ACT = (bf16_t*)(ws + WS_ACT);
    const float* cw = F.in[I_FCW]; const float* cb = F.in[I_FCB];
    constexpr int NIT = 65 + 8, NJ4 = DFF / 4;
    for (int e = F.gw * 64 + lane; e < NIT * NJ4; e += F.NGW * 64) {
        const int it = e / NJ4, j = 4 * (e % NJ4);
        const float *c0, *c1, *p0, *p1; int row0; bool zero_prev = false;
        if (it < 65) { c0 = HEAD + (size_t)(it * 2) * DUP; c1 = c0 + DUP; row0 = it * 256;
            if (it == 0) { zero_prev = true; p0 = c0; p1 = c0; } else { p0 = TAIL + (size_t)((it - 1) * 2) * DUP; p1 = p0 + DUP; } }
        else { const int b = it - 65; c0 = HEADX + (size_t)((1 + b) * 2) * DUP; c1 = c0 + DUP; row0 = TP + 16 * b; p0 = F.in[I_SFFN] + (size_t)b * 2 * DUP; p1 = p0 + DUP; }
        f32x4 o0, o1; float pre0[2][4], pre1[2][4];
#pragma unroll
        for (int bj = 0; bj < 2; ++bj) {
            const int c = bj * DFF + j;
            const f32x4 w0 = *(const f32x4*)(cw + c), w1 = *(const f32x4*)(cw + DUP + c), w2 = *(const f32x4*)(cw + 2 * DUP + c), bb = *(const f32x4*)(cb + c);
            const f32x4 x0 = *(const f32x4*)(c0 + c), x1 = *(const f32x4*)(c1 + c);
            f32x4 q0 = *(const f32x4*)(p0 + c), q1 = *(const f32x4*)(p1 + c);
            if (zero_prev) { q0 = (f32x4){0.f, 0.f, 0.f, 0.f}; q1 = q0; }
#pragma unroll
            for (int i = 0; i < 4; ++i) { pre0[bj][i] = bb[i] + w2[i] * x0[i] + w1[i] * q1[i] + w0[i] * q0[i]; pre1[bj][i] = bb[i] + w2[i] * x1[i] + w1[i] * x0[i] + w0[i] * q1[i]; }
        }
#pragma unroll
        for (int i = 0; i < 4; ++i) { o0[i] = gelu_tanh(pre0[0][i]) * pre0[1][i]; o1[i] = gelu_tanh(pre1[0][i]) * pre1[1][i]; }
        u32x2 w0p, w1p; w0p.x = pk2(o0[0], o0[1]); w0p.y = pk2(o0[2], o0[3]); w1p.x = pk2(o1[0], o1[1]); w1p.y = pk2(o1[2], o1[3]);
        *(u32x2*)(ACT + (size_t)row0 * DFF + j) = w0p; *(u32x2*)(ACT + (size_t)(row0 + 1) * DFF + j) = w1p;
    }
    for (int e = F.gw * 64 + lane; e < 9 * 2 * DUP; e += F.NGW * 64) {
        const int gq = e / (2 * DUP), r = e % (2 * DUP);
        const float v = TAILX[(size_t)gq * 2 * DUP + r];
        if (gq == 0) F.out[O_PF + r] = v; else F.out[O_SF + (size_t)(gq - 1) * 2 * DUP + r] = v;
    }
}
__device__ __forceinline__ void p8_final(Frame& F) {
    const int lane = lane_asm();
    const float* X2 = (const float*)(F.ws + WS_X1); const float* SS2 = (const float*)(F.ws + WS_SS2); const float* gf = F.in[I_GFIN];
    for (int m = NMETA + F.gw; m < MREAL; m += F.NGW) {
        float* o = m < TP ? F.out + O_YP + (size_t)(m - NMETA) * D : F.out + O_YS + (size_t)(m - TP) * D;
        const f32x4 s = *(const f32x4*)(SS2 + (size_t)m * 4);
        const float rs = 1.0f / sqrtf(((s[0] + s[1]) + (s[2] + s[3])) * (1.0f / D) + EPS);
        const f32x4* x4 = (const f32x4*)(X2 + (size_t)m * D) + lane; const f32x4* g4 = (const f32x4*)gf + lane; f32x4* o4 = (f32x4*)o + lane;
#pragma unroll
        for (int j = 0; j < 4; ++j) o4[64 * j] = x4[64 * j] * rs * g4[64 * j];
    }
}

template <int LO, int HI>
__device__ __forceinline__ void mk_body(const Args& args, unsigned char* lds_raw) {
    Frame F;
    F.lds = (LAS unsigned char*)lds_raw;
    F.wave = __builtin_amdgcn_readfirstlane((int)threadIdx.x >> 6);
    F.G = gridDim.x; F.gw = blockIdx.x * NWAVES + F.wave; F.NGW = F.G * NWAVES;
    F.in = args.in; F.out = args.out; F.ws = args.ws;
    unsigned char* ws = args.ws;
    for (int u = threadIdx.x; u < (LDS_BYTES - LDSCTL_OFF) / 4; u += NWAVES * 64) ((LAS unsigned*)(F.lds + LDSCTL_OFF))[u] = 0u;
    __syncthreads();
    XcdBarrier bar; bar.bar = (unsigned*)(ws + WS_CTL) + CW_BAR; bar.x = 0; bar.st = nullptr;
    if (LO < 0) bar = xcd_barrier_post((unsigned*)(ws + WS_CTL) + CW_BAR, (volatile LAS unsigned*)(F.lds + MISC_OFF) + 8, threadIdx.x == 0);
    const int lo = LO < 0 ? args.ph_lo : LO, hi = LO < 0 ? args.ph_hi : HI;
#ifndef PHASE_MASK
#define PHASE_MASK 0x1ff
#endif
#define IN(k) (((PHASE_MASK >> (k)) & 1) && lo <= (k) && (k) < hi)
#define SEAM(k) do { if (IN(k) && IN((k) + 1)) xcd_barrier(bar, F.wave); } while (0)
    if (IN(0)) { p0_prologue(F); } SEAM(0);
    if (IN(1)) {
        pg8::Gemm g{(const bf16_t*)(ws + WS_XN0), (const bf16_t*)(ws + WS_WIN), MPAD, DIN, D}; pg8::StaticOrder S; S.init(MPAD, DIN, F.G, (int)blockIdx.x);
        pg8::EpiBf16 E{(bf16_t*)(ws + WS_U), DIN};
        pg8::gemm_phase<pg8::EpiBf16>(F.lds, g, S, E, F.wave);
    } SEAM(1);
    if (IN(2)) { p2_phase<false>(F); } SEAM(2);
    if (IN(3)) { p2_phase<true>(F); } SEAM(3);
    if (IN(4)) {
        pg8::Gemm g{(const bf16_t*)(ws + WS_Z), (const bf16_t*)(ws + WS_WOUT), MPAD, D, D}; pg8::StaticOrder S; S.init(MPAD, D, F.G, (int)blockIdx.x);
        pg8::EpiResid<true> E{F.in[I_XP], F.in[I_XS], F.in[I_META], (float*)(ws + WS_X1), (bf16_t*)(ws + WS_XB1), (float*)(ws + WS_SS1), (LAS float*)(F.lds + BND_OFF)};
        pg8::gemm_phase<pg8::EpiResid<true>>(F.lds, g, S, E, F.wave);
    } SEAM(4);
    if (IN(5)) {
        pg8::Gemm g{(const bf16_t*)(ws + WS_XB1), (const bf16_t*)(ws + WS_WUP), MPAD, DUP, D}; pg8::StaticOrder S; S.init(MPAD, DUP, F.G, (int)blockIdx.x);
        pg8::EpiUpGate E{(const float*)(ws + WS_SS1), F.in[I_FCW], F.in[I_FCB], (bf16_t*)(ws + WS_ACT), (float*)(ws + WS_HEAD), (float*)(ws + WS_TAIL), (float*)(ws + WS_HEADX), (float*)(ws + WS_TAILX),
                            (LAS float*)(F.lds + BND_OFF)};
        pg8::gemm_phase<pg8::EpiUpGate>(F.lds, g, S, E, F.wave);
    } SEAM(5);
    if (IN(6)) { p6_fixup(F); } SEAM(6);
    if (IN(7)) {
        pg8::Gemm g{(const bf16_t*)(ws + WS_ACT), (const bf16_t*)(ws + WS_WDN), MPAD, D, DFF}; pg8::StaticOrder S; S.init(MPAD, D, F.G, (int)blockIdx.x);
        pg8::EpiResid<false> E{nullptr, nullptr, nullptr, (float*)(ws + WS_X1), nullptr, (float*)(ws + WS_SS2), (LAS float*)(F.lds + BND_OFF)};
        pg8::gemm_phase<pg8::EpiResid<false>>(F.lds, g, S, E, F.wave);
    } SEAM(7);
    if (IN(8)) { p8_final(F); }
#undef IN
#undef SEAM
}
#if MK_N_LAUNCHES == 1
__global__ void __launch_bounds__(NWAVES * 64, 2) mk_fwd(Args args) {
    extern __shared__ __attribute__((aligned(16))) unsigned char lds_raw[];
    mk_body<-1, -1>(args, lds_raw);
}
#else
template <int PH> __global__ void __launch_bounds__(NWAVES * 64, 2) mk_ph(Args args) {
    extern __shared__ __attribute__((aligned(16))) unsigned char lds_raw[];
    mk_body<PH, PH + 1>(args, lds_raw);
}
#endif

#if MK_N_LAUNCHES != 1
typedef void (*kern_t)(Args);
static kern_t phase_kernel(int k) {
    switch (k) { case 0: return mk_ph<0>; case 1: return mk_ph<1>; case 2: return mk_ph<2>; case 3: return mk_ph<3>; case 4: return mk_ph<4>;
                 case 5: return mk_ph<5>; case 6: return mk_ph<6>; case 7: return mk_ph<7>; default: return mk_ph<8>; }
}
#endif
extern "C" void kernel_launch(void* const* d_in, const int* in_sizes, int n_in, void* d_out, int out_size, void* d_ws, size_t ws_size, hipStream_t stream) {
    static int grid = 0;
    if (grid == 0) {
        if (n_in != 28 || ws_size < WS_END) { fprintf(stderr, "kernel_launch: built for 28 inputs and >= %zu bytes of workspace; got n_in %d, ws %zu\n", (size_t)WS_END, n_in, ws_size); grid = -1; return; }
        int dev = 0, cus = 0, per_cu = 0;
        if (hipGetDevice(&dev) != hipSuccess || hipDeviceGetAttribute(&cus, hipDeviceAttributeMultiprocessorCount, dev) != hipSuccess) { grid = -1; return; }
#if MK_N_LAUNCHES == 1
        if (hipFuncSetAttribute((const void*)mk_fwd, hipFuncAttributeMaxDynamicSharedMemorySize, LDS_BYTES) != hipSuccess) { fprintf(stderr, "kernel_launch: hipFuncSetAttribute failed\n"); grid = -1; return; }
        if (hipOccupancyMaxActiveBlocksPerMultiprocessor(&per_cu, (const void*)mk_fwd, NWAVES * 64, LDS_BYTES) != hipSuccess || per_cu < 1) {
            fprintf(stderr, "kernel_launch: occupancy query says %d blocks per CU\n", per_cu); per_cu = 1; }
#else
        for (int k = 0; k < NPH; ++k) if (hipFuncSetAttribute((const void*)phase_kernel(k), hipFuncAttributeMaxDynamicSharedMemorySize, LDS_BYTES) != hipSuccess) { fprintf(stderr, "kernel_launch: hipFuncSetAttribute failed\n"); grid = -1; return; }
        (void)per_cu;
#endif
        (void)hipGetLastError();
        grid = cus;
    }
    if (grid < 0) return;
    (void)hipMemsetAsync((char*)d_ws + WS_CTL, 0, CTL_ZERO_BYTES, stream);
    Args a{};
    for (int i = 0; i < 28; ++i) a.in[i] = (const float*)d_in[i];
    a.out = (float*)d_out; a.ws = (unsigned char*)d_ws;
#if MK_N_LAUNCHES == 1
    a.ph_lo = 0; a.ph_hi = NPH; a.li = 0;
    hipLaunchKernelGGL(mk_fwd, dim3(grid), dim3(NWAVES * 64), LDS_BYTES, stream, a);
#else
    for (int li = 0; li < NPH; ++li) { a.ph_lo = li; a.ph_hi = li + 1; a.li = li;
        hipLaunchKernelGGL(phase_kernel(li), dim3(grid), dim3(NWAVES * 64), LDS_BYTES, stream, a); }
#endif
}
```

```cpp
#include <hip/hip_runtime.h>
#include <cstdio>
#include <cstdint>

#ifndef MK_N_LAUNCHES
#define MK_N_LAUNCHES 1
#endif

#define GAS __attribute__((address_space(1)))
#define LAS __attribute__((address_space(3)))
typedef unsigned short bf16_t;
typedef short bf16x8 __attribute__((ext_vector_type(8)));
typedef float f32x4 __attribute__((ext_vector_type(4)));
typedef float f32x2 __attribute__((ext_vector_type(2)));
typedef unsigned u32x4 __attribute__((ext_vector_type(4)));
typedef unsigned u32x2 __attribute__((ext_vector_type(2)));

constexpr int D = 1024, TP = 16400, MMAIN = 16384, XROW0 = 16384, MREAL = 16528, MPAD = 16640, NMETA = 16, NXG = 9;
constexpr int DIN = 1536, DFF = 3072, DUP = 6144, DLRU = 512;
constexpr int CHUNK = 80, NCHUNK_P = 205, NITEM2 = 213;
constexpr int UROWS = MPAD + 9 * 16;
constexpr float EPS = 1e-6f;
constexpr int NPH = 9;
constexpr size_t O_YP = 0, O_YS = 16777216, O_PH = 16908288, O_PC = 16908800, O_PP = 16910336, O_PF = 16918016,
                 O_SH = 16930304, O_SC = 16934400, O_SP = 16946688, O_SF = 17008128;
constexpr size_t MiB = 1u << 20, KiB = 1024;
constexpr size_t WS_CTL = 0, CTL_ZERO_BYTES = 1 * MiB;
constexpr size_t WS_WIN = 1 * MiB, WS_WOUT = 4 * MiB, WS_WUP = 6 * MiB, WS_WDN = 18 * MiB;
constexpr size_t WS_WA = 24 * MiB, WS_WX = 24 * MiB + 64 * KiB, WS_PW = 24 * MiB + 128 * KiB, WS_LSL = 24 * MiB + 256 * KiB;
constexpr size_t WS_RSL = 24 * MiB + 320 * KiB, WS_RSP = 24 * MiB + 448 * KiB, WS_SS1X = 24 * MiB + 576 * KiB, WS_SS2X = 24 * MiB + 608 * KiB, WS_TAILM = 24 * MiB + 640 * KiB;
constexpr size_t WS_AGGA = 25 * MiB, WS_AGGH = 25 * MiB + 512 * KiB;
constexpr size_t WS_SS1 = 26 * MiB, WS_SS2 = 28 * MiB, WS_HEAD = 30 * MiB, WS_TAIL = 34 * MiB;
constexpr size_t WS_XN0 = 40 * MiB, WS_U = 73 * MiB, WS_Z = 123 * MiB, WS_X1 = 156 * MiB, WS_XB1 = 221 * MiB, WS_ACT = 40 * MiB, WS_END = 254 * MiB;
static_assert(WS_XN0 + (size_t)MPAD * D * 2 <= WS_U && WS_U + (size_t)UROWS * DIN * 2 <= WS_Z && WS_Z + (size_t)MPAD * D * 2 <= WS_X1 &&
              WS_X1 + (size_t)MPAD * D * 4 <= WS_XB1 && WS_XB1 + (size_t)MPAD * D * 2 <= WS_END && WS_ACT + (size_t)MPAD * DFF * 2 <= WS_X1, "ws map");
constexpr int CW_BAR = 4096;

#define LDS_WAIT() asm volatile("s_waitcnt lgkmcnt(0)" ::: "memory")
#define VM_WAIT() asm volatile("s_waitcnt vmcnt(0)" ::: "memory")
#define WG_BARRIER() do { asm volatile("s_waitcnt lgkmcnt(0)" ::: "memory"); __builtin_amdgcn_s_barrier(); asm volatile("" ::: "memory"); } while (0)
#define RLX_AGENT __ATOMIC_RELAXED, __HIP_MEMORY_SCOPE_AGENT
__device__ __forceinline__ unsigned f2bf(float f) { unsigned u = __builtin_bit_cast(unsigned, f); return (u + 0x7fffu + ((u >> 16) & 1u)) >> 16; }
__device__ __forceinline__ unsigned pk2(float lo, float hi) { return f2bf(lo) | (f2bf(hi) << 16); }
__device__ __forceinline__ float bflo(unsigned w) { return __builtin_bit_cast(float, w << 16); }
__device__ __forceinline__ float bfhi(unsigned w) { return __builtin_bit_cast(float, w & 0xffff0000u); }
__device__ __forceinline__ void unpack8(const u32x4 w, float (&o)[8]) {
    o[0] = bflo(w.x); o[1] = bfhi(w.x); o[2] = bflo(w.y); o[3] = bfhi(w.y); o[4] = bflo(w.z); o[5] = bfhi(w.z); o[6] = bflo(w.w); o[7] = bfhi(w.w); }
__device__ __forceinline__ u32x4 pack8(const float (&v)[8]) { u32x4 w; w.x = pk2(v[0], v[1]); w.y = pk2(v[2], v[3]); w.z = pk2(v[4], v[5]); w.w = pk2(v[6], v[7]); return w; }
template <int CTRL> __device__ __forceinline__ float dppf(float old, float src) {
    return __builtin_bit_cast(float, __builtin_amdgcn_update_dpp(__builtin_bit_cast(int, old), __builtin_bit_cast(int, src), CTRL, 0xF, 0xF, false)); }
template <int CTRL> __device__ __forceinline__ unsigned dppu(unsigned old, unsigned src) {
    return (unsigned)__builtin_amdgcn_update_dpp((int)old, (int)src, CTRL, 0xF, 0xF, false); }
#define DPP_SHR(n) (0x110 + (n))
#define DPP_ROR(n) (0x120 + (n))
template <int K> __device__ __forceinline__ u32x4 shift_tok(const u32x4 prev, const u32x4 cur) {
    u32x4 r;
    r.x = dppu<DPP_SHR(K)>(dppu<DPP_ROR(K)>(0u, prev.x), cur.x); r.y = dppu<DPP_SHR(K)>(dppu<DPP_ROR(K)>(0u, prev.y), cur.y);
    r.z = dppu<DPP_SHR(K)>(dppu<DPP_ROR(K)>(0u, prev.z), cur.z); r.w = dppu<DPP_SHR(K)>(dppu<DPP_ROR(K)>(0u, prev.w), cur.w);
    return r; }
__device__ __forceinline__ float fast_sigmoid(float x) { return __builtin_amdgcn_rcpf(1.0f + __builtin_amdgcn_exp2f(-1.4426950408889634f * x)); }
__device__ __forceinline__ float gelu_tanh(float x) {
    const float t = x * (-2.3022081983f + -0.1029432396f * x * x);
    return x * __builtin_amdgcn_rcpf(1.0f + __builtin_amdgcn_exp2f(t)); }
template <class T> __device__ __forceinline__ const T& gld(const void* base, unsigned byteoff) { return *(const T*)((const char*)base + byteoff); }
template <class T> __device__ __forceinline__ T& gst(void* base, unsigned byteoff) { return *(T*)((char*)base + byteoff); }
__device__ __forceinline__ int lane_asm() { int l; asm volatile("v_mbcnt_lo_u32_b32 %0, -1, 0\n\tv_mbcnt_hi_u32_b32 %0, -1, %0" : "=v"(l)); return l; }
__device__ __forceinline__ float wave_sum(float v) {
#pragma unroll
    for (int o = 1; o < 64; o <<= 1) v += __shfl_xor(v, o);
    return v; }
__device__ __forceinline__ const float* xrow_ptr(const float* xp, const float* xs, const float* meta, int r) {
    if (r < MMAIN) return xp + (size_t)r * D;
    if (r < TP) return meta + (size_t)(r - MMAIN) * D;
    if (r < MREAL) return xs + (size_t)(r - TP) * D;
    return nullptr; }
__device__ __forceinline__ unsigned cvt_pk_bf16(float lo, float hi) { unsigned r; asm volatile("v_cvt_pk_bf16_f32 %0, %1, %2" : "=v"(r) : "v"(lo), "v"(hi)); return r; }

namespace pg8 {
constexpr int BM = 256, BK = 64, HALF = 128, HTB = HALF * BK * 2, STAGE_BYTES = 8 * HTB, NXCD = 8, WGM = 8;
__host__ __device__ __forceinline__ int lds_byte(int r, int c) { const int st = (r >> 4) * 2 + (c >> 5), rr = r & 15, cc = c & 31, ob = rr * 64 + cc * 2; return st * 1024 + (ob ^ (((ob >> 9) & 1) << 5)); }
__host__ __device__ __forceinline__ void stage_rc(int b, int& R, int& C) { const int st = b / 1024, sb = b % 1024, swz = sb ^ (((sb >> 9) & 1) << 5); R = (st >> 1) * 16 + swz / 64; C = (st & 1) * 32 + (swz % 64) / 2; }
__host__ __device__ __forceinline__ int perm32(int rho) { const int n = rho >> 4, i = rho & 15; return 8 * (i >> 2) + 4 * n + (i & 3); }
struct Unit { int pm, pn; };
struct Gemm { const bf16_t* A; const bf16_t* Bt; int M, N, K; };
struct StaticOrder {
    int nM, nN, nwg, G, c;
    __host__ __device__ void init(int M, int N, int G_, int c_) { nM = M / BM; nN = N / BM; nwg = nM * nN; G = G_; c = c_; }
    __host__ __device__ bool next(int i, Unit& u) const {
        const long L = (long)i * G + c; if (L >= nwg) return false;
        int wgid = (int)L; { const int q = nwg / NXCD, r = nwg % NXCD, xcd = wgid % NXCD, off = wgid / NXCD; wgid = (xcd < r ? xcd * (q + 1) : r * (q + 1) + (xcd - r) * q) + off; }
        const int nig = WGM * nN, gid = wgid / nig, fm = gid * WGM, gsz = (nM - fm) < WGM ? (nM - fm) : WGM;
        u.pm = fm + ((wgid % nig) % gsz); u.pn = (wgid % nig) / gsz; return true;
    }
};

struct EpiBf16 {
    static constexpr bool PERM = true;
    bf16_t* O; int ldc;
    __device__ __forceinline__ void mid(f32x4 (&)[2][2][4][2], const Unit&, int, int, int, int) const {}
    __device__ __forceinline__ void operator()(f32x4 (&acc)[2][2][4][2], const Unit& u, int wr, int wc, int fr, int fq) const {
        const int row0 = u.pm * BM + wr * 64 + fr, col0 = u.pn * BM + wc * 32 + 8 * fq;
#pragma unroll
        for (int ai = 0; ai < 2; ++ai)
#pragma unroll
            for (int m = 0; m < 4; ++m) { bf16_t* rowp = O + (size_t)(row0 + ai * HALF + m * 16) * ldc + col0;
#pragma unroll
                for (int bj = 0; bj < 2; ++bj) { const f32x4 v0 = acc[ai][bj][m][0], v1 = acc[ai][bj][m][1];
                    u32x4 w; w.x = cvt_pk_bf16(v0[0], v0[1]); w.y = cvt_pk_bf16(v0[2], v0[3]); w.z = cvt_pk_bf16(v1[0], v1[1]); w.w = cvt_pk_bf16(v1[2], v1[3]);
                    *(u32x4*)(rowp + bj * HALF) = w; } }
    }
};
template <bool FROM_X> struct EpiResid {
    static constexpr bool PERM = true;
    const float *xp, *xs, *meta;
    const float *RSL, *RSP;
    float* X;
    bf16_t* XB;
    float* SS;
    LAS float* red;
    __device__ __forceinline__ void mid(f32x4 (&acc)[2][2][4][2], const Unit& u, int wr, int wc, int fr, int fq) const {
        if (!FROM_X) return;
        asm volatile("" : "+v"(fr));
#pragma unroll
        for (int ai = 0; ai < 2; ++ai)
#pragma unroll
            for (int m = 0; m < 4; ++m) { const unsigned ro = (unsigned)(u.pm * BM + ai * HALF + wr * 64 + m * 16 + fr) * 4u;
                const float r = gld<float>(RSL, ro) * __builtin_amdgcn_rcpf(gld<float>(RSP, ro));
#pragma unroll
                for (int bj = 0; bj < 2; ++bj)
#pragma unroll
                    for (int n = 0; n < 2; ++n) acc[ai][bj][m][n] = acc[ai][bj][m][n] * r; }
    }
    __device__ __forceinline__ void operator()(f32x4 (&acc)[2][2][4][2], const Unit& u, int wr, int wc, int fr, int fq) const {
        asm volatile("" : "+v"(fr), "+v"(fq));
        const int col0 = u.pn * BM + wc * 32 + 8 * fq;
#pragma unroll
        for (int ai = 0; ai < 2; ++ai)
#pragma unroll
            for (int m = 0; m < 4; ++m) {
                const int row = u.pm * BM + ai * HALF + wr * 64 + m * 16 + fr;
                const float* br = FROM_X ? xrow_ptr(xp, xs, meta, row) : (X + (size_t)row * D);
                const float sc = FROM_X ? gld<float>(RSP, (unsigned)row * 4u) : 1.0f;
                float ss = 0.f;
#pragma unroll
                for (int bj = 0; bj < 2; ++bj) {
                    f32x4 b0 = (f32x4){0.f, 0.f, 0.f, 0.f}, b1 = b0;
                    if (br) { b0 = *(const f32x4*)(br + col0 + bj * HALF); b1 = *(const f32x4*)(br + col0 + bj * HALF + 4); }
                    const f32x4 v0 = acc[ai][bj][m][0] * sc + b0, v1 = acc[ai][bj][m][1] * sc + b1;
                    float* o = X + (size_t)row * D + col0 + bj * HALF;
                    *(f32x4*)o = v0; *(f32x4*)(o + 4) = v1;
                    if (XB) { u32x4 w; w.x = cvt_pk_bf16(v0[0], v0[1]); w.y = cvt_pk_bf16(v0[2], v0[3]); w.z = cvt_pk_bf16(v1[0], v1[1]); w.w = cvt_pk_bf16(v1[2], v1[3]);
                        *(u32x4*)(XB + (size_t)row * D + col0 + bj * HALF) = w; }
                    ss += (v0[0] * v0[0] + v0[1] * v0[1]) + (v0[2] * v0[2] + v0[3] * v0[3]) + (v1[0] * v1[0] + v1[1] * v1[1]) + (v1[2] * v1[2] + v1[3] * v1[3]);
                }
                ss += __shfl_xor(ss, 16); ss += __shfl_xor(ss, 32);
                if (fq == 0) red[(ai * HALF + wr * 64 + m * 16 + fr) * 4 + wc] = ss;
            }
        WG_BARRIER();
        const int t = (wr * 4 + wc) * 64 + fq * 16 + fr;
        if (t < BM) { const f32x4 v = *(const LAS f32x4*)(red + t * 4); SS[(size_t)(u.pm * BM + t) * 4 + u.pn] = (v[0] + v[1]) + (v[2] + v[3]); }
    }
};
struct EpiUpGate {
    static constexpr bool PERM = true;
    const float* SS1; const float* cw; const float* cb;
    bf16_t* ACT; float *HEAD, *TAIL;
    LAS float* bnd;
    __device__ __forceinline__ void mid(f32x4 (&)[2][2][4][2], const Unit&, int, int, int, int) const {}
    __device__ __forceinline__ void operator()(f32x4 (&acc)[2][2][4][2], const Unit& u, int wr, int wc, int fr, int fq) const {
        const unsigned lcol = wc * 32 + 8 * fq, jc = u.pn * 128 + lcol;
        const unsigned row0 = u.pm * BM + wr * 64 + fr;
#pragma unroll
        for (int ai = 0; ai < 2; ++ai)
#pragma unroll
            for (int m = 0; m < 4; ++m) {
                const f32x4 s = gld<f32x4>(SS1, (row0 + 128u * ai + 16u * m) * 16u);
                const float rs = __builtin_amdgcn_rsqf(((s[0] + s[1]) + (s[2] + s[3])) * (1.0f / D) + EPS);
#pragma unroll
                for (int bj = 0; bj < 2; ++bj)
#pragma unroll
                    for (int n = 0; n < 2; ++n) acc[ai][bj][m][n] = acc[ai][bj][m][n] * rs;
            }
        const unsigned co = jc * 4u;
        if (fr >= 14) {
#pragma unroll
            for (int ai = 0; ai < 2; ++ai)
#pragma unroll
                for (int bj = 0; bj < 2; ++bj)
#pragma unroll
                    for (int n = 0; n < 2; ++n) *(LAS f32x4*)(bnd + ((((2 * ai + wr) * 2 + (fr - 14)) * 2 + bj) * 128 + lcol + 4 * n)) = acc[ai][bj][3][n];
            if (wr == 1) {
                const unsigned to = (unsigned)(u.pm * 2 + (fr - 14)) * (DUP * 4u) + co;
#pragma unroll
                for (int bj = 0; bj < 2; ++bj)
#pragma unroll
                    for (int n = 0; n < 2; ++n) gst<f32x4>(TAIL, to + bj * (DFF * 4u) + 16u * n) = acc[1][bj][3][n];
            }
        }
        if (wr == 0 && fr < 2) {
            const unsigned ho = (unsigned)(u.pm * 2 + fr) * (DUP * 4u) + co;
#pragma unroll
            for (int bj = 0; bj < 2; ++bj)
#pragma unroll
                for (int n = 0; n < 2; ++n) gst<f32x4>(HEAD, ho + bj * (DFF * 4u) + 16u * n) = acc[0][bj][0][n];
        }
        WG_BARRIER();
        const unsigned ao = row0 * (DFF * 2u) + jc * 2u;
#pragma unroll
        for (int n = 0; n < 2; ++n) {
            f32x4 w0[2], w1[2], w2[2], bb[2];
#pragma unroll
            for (int bj = 0; bj < 2; ++bj) { const unsigned c = co + bj * (DFF * 4u) + 16u * n;
                w0[bj] = gld<f32x4>(cw, c); w1[bj] = gld<f32x4>(cw, c + DUP * 4u); w2[bj] = gld<f32x4>(cw, c + 2u * DUP * 4u); bb[bj] = gld<f32x4>(cb, c); }
#pragma unroll
            for (int ai = 0; ai < 2; ++ai) {
                f32x4 pg[2];
                const int slotp = 2 * ai + wr - 1;
#pragma unroll
                for (int bj = 0; bj < 2; ++bj) pg[bj] = slotp >= 0 ? *(const LAS f32x4*)(bnd + (((slotp * 2 + (fr & 1)) * 2 + bj) * 128 + lcol + 4 * n)) : (f32x4){0.f, 0.f, 0.f, 0.f};
#pragma unroll
                for (int m = 0; m < 4; ++m) {
                    float pre[2][4];
#pragma unroll
                    for (int bj = 0; bj < 2; ++bj)
#pragma unroll
                        for (int i = 0; i < 4; ++i) {
                            const float cur = acc[ai][bj][m][n][i], pv = pg[bj][i];
                            const float p1 = dppf<DPP_SHR(1)>(dppf<DPP_ROR(1)>(0.f, pv), cur);
                            const float p2 = dppf<DPP_SHR(2)>(dppf<DPP_ROR(2)>(0.f, pv), cur);
                            pre[bj][i] = bb[bj][i] + w2[bj][i] * cur + w1[bj][i] * p1 + w0[bj][i] * p2;
                        }
                    u32x2 w;
                    w.x = cvt_pk_bf16(gelu_tanh(pre[0][0]) * pre[1][0], gelu_tanh(pre[0][1]) * pre[1][1]);
                    w.y = cvt_pk_bf16(gelu_tanh(pre[0][2]) * pre[1][2], gelu_tanh(pre[0][3]) * pre[1][3]);
                    gst<u32x2>(ACT, ao + (unsigned)(128 * ai + 16 * m) * (DFF * 2u) + 8u * n) = w;
#pragma unroll
                    for (int bj = 0; bj < 2; ++bj) pg[bj] = acc[ai][bj][m][n];
                }
            }
        }
    }
};

template <class Epi, bool MID>
__device__ __forceinline__ void gemm_phase(LAS unsigned char* lds, const Gemm g, const StaticOrder& S, const Epi& E, const int wid) {
    const int lane = lane_asm(), tid = wid * 64 + lane, wr = wid >> 2, wc = wid & 3, fr = lane & 15, fq = lane >> 4;
    const int K = g.K, nt = K / BK;
    unsigned voffA[2], voffB[2];
#pragma unroll
    for (int i = 0; i < 2; ++i) { int R, C; stage_rc(tid * 16 + i * 8192, R, C); const int Rb = Epi::PERM ? ((R & ~31) + perm32(R & 31)) : R;
        voffA[i] = (unsigned)(R * K + C) * 2u; voffB[i] = (unsigned)(Rb * K + C) * 2u; }
    const size_t kstep = (size_t)(BK * 2);
    const size_t hstep = (size_t)HALF * K * 2;
    const size_t tstep = 2 * hstep;
    const unsigned ldsw = (unsigned)wid * 1024u;
    const int aoff = lds_byte(wr * 64 + fr, fq * 8), boff = lds_byte(wc * 32 + fr, fq * 8);
#define PG8_SA(b, h) (((b) * 2 + (h)) * HTB)
#define PG8_SB(b, h) ((4 + (b) * 2 + (h)) * HTB)
#define PG8_STAGE(bufoff, gbase, voff) do { _Pragma("unroll") for (int _i = 0; _i < 2; ++_i) \
        __builtin_amdgcn_global_load_lds((const unsigned*)((const char*)(gbase) + (voff)[_i]), (LAS unsigned*)(lds + (bufoff) + ldsw + _i * 8192), 16, 0, 0); } while (0)
#define PG8_LDA(dst, b, h) do { _Pragma("unroll") for (int m = 0; m < 4; ++m) _Pragma("unroll") for (int k = 0; k < 2; ++k) dst[m][k] = *(const LAS bf16x8*)(lds + PG8_SA(b, h) + aoff + m * 2048 + k * 1024); } while (0)
#define PG8_LDB(dst, b, h) do { _Pragma("unroll") for (int n = 0; n < 2; ++n) _Pragma("unroll") for (int k = 0; k < 2; ++k) dst[n][k] = *(const LAS bf16x8*)(lds + PG8_SB(b, h) + boff + n * 2048 + k * 1024); } while (0)
#define PG8_MMA(ai, bj, At, Bt) do { __builtin_amdgcn_s_setprio(1); _Pragma("unroll") for (int m = 0; m < 4; ++m) _Pragma("unroll") for (int n = 0; n < 2; ++n) _Pragma("unroll") for (int k = 0; k < 2; ++k) \
        acc[ai][bj][m][n] = __builtin_amdgcn_mfma_f32_16x16x32_bf16(Bt[n][k], At[m][k], acc[ai][bj][m][n], 0, 0, 0); __builtin_amdgcn_s_setprio(0); } while (0)
#define PG8_WAIT_V(n) asm volatile("s_waitcnt vmcnt(" #n ")" ::: "memory")
#define PG8_WAIT_L(n) asm volatile("s_waitcnt lgkmcnt(" #n ")" ::: "memory")
#define PG8_BAR __builtin_amdgcn_s_barrier()
#define PG8_SCHED __builtin_amdgcn_sched_barrier(0)
    Unit cur, nxt; int ui = 0;
    if (!S.next(0, cur)) return;
    f32x4 acc[2][2][4][2];
#pragma unroll
    for (int a = 0; a < 2; ++a)
#pragma unroll
        for (int b = 0; b < 2; ++b)
#pragma unroll
            for (int m = 0; m < 4; ++m)
#pragma unroll
                for (int n = 0; n < 2; ++n) acc[a][b][m][n] = (f32x4){0.f, 0.f, 0.f, 0.f};
    bf16x8 At[4][2], B0[2][2], B1[2][2];
    const char* cA = (const char*)g.A + (size_t)cur.pm * tstep; const char* cB = (const char*)g.Bt + (size_t)cur.pn * tstep;
    PG8_STAGE(PG8_SB(0, 0), cB, voffB); PG8_STAGE(PG8_SB(0, 1), cB + hstep, voffB); PG8_STAGE(PG8_SA(0, 0), cA, voffA); PG8_STAGE(PG8_SA(0, 1), cA + hstep, voffA);
    if (wr == 1) PG8_BAR;
    PG8_WAIT_V(2); PG8_BAR;
    PG8_STAGE(PG8_SB(1, 0), cB + kstep, voffB); PG8_STAGE(PG8_SA(1, 0), cA + kstep, voffA); PG8_STAGE(PG8_SB(1, 1), cB + hstep + kstep, voffB);
    PG8_WAIT_V(6); PG8_BAR;
    for (;;) {
        const bool has_next = S.next(ui + 1, nxt);
        const char* nA = has_next ? (const char*)g.A + (size_t)nxt.pm * tstep : cA; const char* nB = has_next ? (const char*)g.Bt + (size_t)nxt.pn * tstep : cB;
        for (int t = 0; t < nt; t += 2) {
            const bool last = (t == nt - 2);
            if (MID && t == nt / 2) E.mid(acc, cur, wr, wc, fr, fq);
            const char* a1 = cA + (size_t)(t + 1) * kstep;
            const char* a2 = last ? nA : cA + (size_t)(t + 2) * kstep; const char* b2 = last ? nB : cB + (size_t)(t + 2) * kstep;
            const char* a3 = a2 + kstep; const char* b3 = b2 + kstep;
            PG8_LDB(B0, 0, 0); PG8_LDB(B1, 0, 1); PG8_SCHED; PG8_LDA(At, 0, 0); PG8_STAGE(PG8_SA(1, 1), a1 + hstep, voffA);
            PG8_WAIT_V(8); PG8_WAIT_L(0); PG8_BAR; PG8_MMA(0, 0, At, B0); PG8_MMA(0, 1, At, B1); PG8_BAR; PG8_SCHED;
            PG8_LDA(At, 0, 1); PG8_STAGE(PG8_SB(0, 0), b2, voffB); PG8_STAGE(PG8_SB(0, 1), b2 + hstep, voffB); PG8_STAGE(PG8_SA(0, 0), a2, voffA);
            PG8_WAIT_V(8); PG8_WAIT_L(0); PG8_BAR; PG8_MMA(1, 0, At, B0); PG8_MMA(1, 1, At, B1); PG8_BAR; PG8_SCHED;
            PG8_LDB(B0, 1, 0); PG8_LDB(B1, 1, 1); PG8_SCHED; PG8_LDA(At, 1, 0); PG8_STAGE(PG8_SA(0, 1), a2 + hstep, voffA);
            PG8_WAIT_V(8); PG8_WAIT_L(0); PG8_BAR; PG8_MMA(0, 0, At, B0); PG8_MMA(0, 1, At, B1); PG8_BAR; PG8_SCHED;
            PG8_LDA(At, 1, 1); PG8_STAGE(PG8_SB(1, 0), b3, voffB); PG8_STAGE(PG8_SB(1, 1), b3 + hstep, voffB); PG8_STAGE(PG8_SA(1, 0), a3, voffA);
            PG8_WAIT_V(8); PG8_WAIT_L(0); PG8_BAR; PG8_MMA(1, 0, At, B0); PG8_MMA(1, 1, At, B1); PG8_BAR; PG8_SCHED;
        }
        if (wr == 0) PG8_BAR;
        E(acc, cur, wr, wc, fr, fq);
        if (!has_next) break;
#pragma unroll
        for (int a = 0; a < 2; ++a)
#pragma unroll
            for (int b = 0; b < 2; ++b)
#pragma unroll
                for (int m = 0; m < 4; ++m)
#pragma unroll
                    for (int n = 0; n < 2; ++n) acc[a][b][m][n] = (f32x4){0.f, 0.f, 0.f, 0.f};
        cur = nxt; cA = nA; cB = nB; ++ui;
        if (wr == 1) PG8_BAR;
    }
    PG8_WAIT_V(0);
    PG8_BAR;
#undef PG8_SA
#undef PG8_SB
#undef PG8_STAGE
#undef PG8_LDA
#undef PG8_LDB
#undef PG8_MMA
#undef PG8_WAIT_V
#undef PG8_WAIT_L
#undef PG8_BAR
#undef PG8_SCHED
}
}

constexpr int NWAVES = 8;
constexpr int RING_BYTES = 131072, BND_OFF = RING_BYTES + 1024, LDS_BYTES = 163840, MISC_OFF = LDS_BYTES - 256;
static_assert(BND_OFF + 8192 <= MISC_OFF, "LDS map");

typedef GAS unsigned gu32;
#define XB_TMO      128
#define XB_XCNT(j)  (256  + 64 * (j))
#define XB_XSUB(j)  (1280 + 64 * (j))
#define XB_XGEN(j)  (2304 + 64 * (j))
#define XB_TOP      3328
#define XB_TOPGEN   3392
#define XCD_BAR_WORDS 3456
#define XB_SPIN_CAP (1u << 18)
__device__ __forceinline__ unsigned xb_ld(unsigned* p)              { return __hip_atomic_load(p, __ATOMIC_RELAXED, __HIP_MEMORY_SCOPE_AGENT); }
__device__ __forceinline__ unsigned xb_add(unsigned* p, unsigned v) { return __hip_atomic_fetch_add(p, v, __ATOMIC_RELAXED, __HIP_MEMORY_SCOPE_AGENT); }
__device__ __forceinline__ unsigned xb_xcc_id() { return (unsigned)__builtin_amdgcn_s_getreg((3 << 11) | 20) & 0xFu; }
#define XB_SPIN(cond, bar) do { unsigned _sp = 0; while (cond) { __builtin_amdgcn_s_sleep(1); \
    if ((++_sp & 255u) == 0u) { if (xb_ld(&(bar)[XB_TMO])) break; if (_sp > XB_SPIN_CAP) { atomicAdd(&(bar)[XB_TMO], 1u); break; } } } } while (0)
struct XcdBarrier { unsigned* bar; unsigned x; volatile LAS unsigned* st; };
__device__ __forceinline__ XcdBarrier xcd_barrier_post(unsigned* bar, volatile LAS unsigned* st, bool leader) {
    XcdBarrier b; b.bar = bar; b.x = xb_xcc_id(); b.st = st;
    if (leader) (void)xb_add(&bar[XB_XCNT(b.x)], 1u);
    return b;
}
__device__ __forceinline__ void xcd_barrier_complete(unsigned* bar, unsigned x, unsigned& nloc, unsigned& nx) {
    const unsigned G = gridDim.x * gridDim.y * gridDim.z;
    unsigned sum, cnt, mine, sp = 0u;
    for (;;) {
        sum = 0u; cnt = 0u; mine = 0u;
#pragma unroll
        for (unsigned j = 0; j < 16; ++j) { const unsigned c = xb_ld(&bar[XB_XCNT(j)]); sum += c; cnt += (c > 0u) ? 1u : 0u; mine = (j == x) ? c : mine; }
        if (sum == G) break;
        __builtin_amdgcn_s_sleep(1);
        if ((++sp & 255u) == 0u) { if (xb_ld(&bar[XB_TMO])) break; if (sp > XB_SPIN_CAP) { atomicAdd(&bar[XB_TMO], 1u); break; } }
    }
    nloc = mine > 0u ? mine : 1u; nx = cnt > 0u ? cnt : 1u;
}
__device__ __forceinline__ void xcd_barrier(const XcdBarrier& b, int wave) {
    asm volatile("s_waitcnt vmcnt(0)" ::: "memory");
    __syncthreads();
    if (wave == 0 && lane_asm() == 0) {
        unsigned* bar = b.bar;
        __builtin_amdgcn_s_waitcnt(0);
        unsigned nloc = b.st[0], nx = b.st[1];
        if (nloc == 0u) { xcd_barrier_complete(bar, b.x, nloc, nx); b.st[0] = nloc; b.st[1] = nx; }
        const unsigned old = xb_add(&bar[XB_XSUB(b.x)], 1u);
        const unsigned gen = old / nloc;
        if (old + 1u == (gen + 1u) * nloc) {
            __builtin_amdgcn_fence(__ATOMIC_RELEASE, "agent");
            asm volatile("s_waitcnt vmcnt(0)" ::: "memory");
            const unsigned og = xb_add(&bar[XB_TOP], 1u);
            const unsigned tg = og / nx;
            if (og + 1u == (tg + 1u) * nx) xb_add(&bar[XB_TOPGEN], 1u);
            else XB_SPIN(xb_ld(&bar[XB_TOPGEN]) == tg, bar);
            __builtin_amdgcn_fence(__ATOMIC_ACQUIRE, "agent");
            xb_add(&bar[XB_XGEN(b.x)], 1u);
            asm volatile("s_waitcnt vmcnt(0)" ::: "memory");
        } else {
            XB_SPIN(xb_ld(&bar[XB_XGEN(b.x)]) == gen, bar);
            __builtin_amdgcn_fence(__ATOMIC_ACQUIRE, "agent");
            asm volatile("s_waitcnt vmcnt(0)" ::: "memory");
        }
    }
    __syncthreads();
}

struct Args { const float* in[28]; float* out; unsigned char* ws; int ph_lo, ph_hi, li, pad; };
struct Frame {
    LAS unsigned char* lds; int wave, G, gw, NGW;
    const float* const* in; float* out; unsigned char* ws;
};
enum { I_XP = 0, I_XS, I_SLH, I_SLC, I_SPOOL, I_SFFN, I_META, I_GMIX, I_WIN, I_CLW, I_CLB, I_GAW, I_GAB, I_GXW, I_GXB, I_LAM, I_PW, I_PB, I_PS, I_GNL, I_GNP,
       I_WOUT, I_GFFN, I_WUP, I_FCW, I_FCB, I_WDN, I_GFIN };

template <int NT> __device__ __forceinline__ void mini_mma(const bf16_t* A, unsigned aoff, const bf16_t* Bt, const unsigned (&boff)[NT], int ks0, int ks1, f32x4 (&acc)[NT]) {
#pragma unroll 4
    for (int ks = ks0; ks < ks1; ++ks) {
        const bf16x8 a = gld<bf16x8>(A, aoff + 64u * ks);
#pragma unroll
        for (int n = 0; n < NT; ++n) { const bf16x8 b = gld<bf16x8>(Bt, boff[n] + 64u * ks); acc[n] = __builtin_amdgcn_mfma_f32_16x16x32_bf16(b, a, acc[n], 0, 0, 0); }
    }
}
__device__ __forceinline__ void x4_extras(Frame& F) {
    const int lane = lane_asm(), fr = lane & 15, fq = lane >> 4;
    unsigned char* ws = F.ws;
    const bf16_t* Z = (const bf16_t*)(ws + WS_Z); const bf16_t* WOUT = (const bf16_t*)(ws + WS_WOUT);
    const float* RSL = (const float*)(ws + WS_RSL); const float* RSP = (const float*)(ws + WS_RSP);
    float* X1 = (float*)(ws + WS_X1); bf16_t* XB1 = (bf16_t*)(ws + WS_XB1); float* SS1X = (float*)(ws + WS_SS1X);
    for (int it = F.wave * F.G + (int)blockIdx.x; it < NXG * 32; it += F.NGW) {
        const int gI = it >> 5, cg = it & 31; const unsigned row = XROW0 + 16 * gI + fr;
        const unsigned aoff = (row * D + 8u * fq) * 2u; unsigned boff[2];
#pragma unroll
        for (int n = 0; n < 2; ++n) boff[n] = ((32u * cg + 8u * (fr >> 2) + 4u * n + (fr & 3)) * D + 8u * fq) * 2u;
        f32x4 acc[2] = {(f32x4){0.f, 0.f, 0.f, 0.f}, (f32x4){0.f, 0.f, 0.f, 0.f}};
        mini_mma<2>(Z, aoff, WOUT, boff, 0, 16, acc);
        const float rsp = gld<float>(RSP, row * 4u), ratio = gld<float>(RSL, row * 4u) * __builtin_amdgcn_rcpf(rsp);
        acc[0] = acc[0] * ratio; acc[1] = acc[1] * ratio;
        mini_mma<2>(Z, aoff, WOUT, boff, 16, 32, acc);
        const float* xr = xrow_ptr(F.in[I_XP], F.in[I_XS], F.in[I_META], (int)row);
        const unsigned col = 32u * cg + 8u * fq;
        const f32x4 v0 = acc[0] * rsp + *(const f32x4*)(xr + col), v1 = acc[1] * rsp + *(const f32x4*)(xr + col + 4);
        gst<f32x4>(X1, (row * D + col) * 4u) = v0; gst<f32x4>(X1, (row * D + col) * 4u + 16u) = v1;
        u32x4 wv; wv.x = cvt_pk_bf16(v0[0], v0[1]); wv.y = cvt_pk_bf16(v0[2], v0[3]); wv.z = cvt_pk_bf16(v1[0], v1[1]); wv.w = cvt_pk_bf16(v1[2], v1[3]);
        gst<u32x4>(XB1, (row * D + col) * 2u) = wv;
        float ss = (v0[0] * v0[0] + v0[1] * v0[1]) + (v0[2] * v0[2] + v0[3] * v0[3]) + (v1[0] * v1[0] + v1[1] * v1[1]) + (v1[2] * v1[2] + v1[3] * v1[3]);
        ss += __shfl_xor(ss, 16); ss += __shfl_xor(ss, 32);
        if (fq == 0) SS1X[(16 * gI + fr) * 32 + cg] = ss;
    }
}
__device__ __forceinline__ void x5_extras(Frame& F) {
    const int lane = lane_asm(), fr = lane & 15, fq = lane >> 4;
    unsigned char* ws = F.ws;
    const bf16_t* XB1 = (const bf16_t*)(ws + WS_XB1); const bf16_t* WUP = (const bf16_t*)(ws + WS_WUP);
    const float* SS1X = (const float*)(ws + WS_SS1X); bf16_t* ACT = (bf16_t*)(ws + WS_ACT); float* TAILM = (float*)(ws + WS_TAILM);
    const float* cw = F.in[I_FCW]; const float* cb = F.in[I_FCB];
    for (int it = F.wave * F.G + (int)blockIdx.x; it < NXG * 96; it += F.NGW) {
        const int gI = it / 96, cgI = it % 96; const unsigned row = XROW0 + 16 * gI + fr, j0 = 32u * cgI;
        const unsigned aoff = (row * D + 8u * fq) * 2u; unsigned boff[4];
#pragma unroll
        for (int n = 0; n < 4; ++n) { const unsigned j = j0 + 8u * (fr >> 2) + 4u * (n & 1) + (fr & 3); boff[n] = ((256u * (j >> 7) + (j & 127u) + 128u * (n >> 1)) * D + 8u * fq) * 2u; }
        f32x4 acc[4];
#pragma unroll
        for (int n = 0; n < 4; ++n) acc[n] = (f32x4){0.f, 0.f, 0.f, 0.f};
        mini_mma<4>(XB1, aoff, WUP, boff, 0, 32, acc);
        float rs;
        { const unsigned so = (unsigned)(16 * gI + fr) * 128u; f32x4 s = gld<f32x4>(SS1X, so);
#pragma unroll
          for (int q = 1; q < 8; ++q) s = s + gld<f32x4>(SS1X, so + 16u * q);
          rs = __builtin_amdgcn_rsqf(((s[0] + s[1]) + (s[2] + s[3])) * (1.0f / D) + EPS); }
        const unsigned colbase = j0 + 8u * fq;
        float outv[8];
#pragma unroll
        for (int n = 0; n < 2; ++n) {
            const unsigned ca = (colbase + 4u * n) * 4u, cbo = ca + DFF * 4u;
            const f32x4 ua = acc[n] * rs, ub = acc[2 + n] * rs;
            f32x4 pa = (f32x4){0.f, 0.f, 0.f, 0.f}, pb = pa;
            if (gI > 0) { const unsigned so = (unsigned)((gI - 1) * 2 + (fr & 1)) * (DUP * 4u); pa = gld<f32x4>(F.in[I_SFFN], so + ca); pb = gld<f32x4>(F.in[I_SFFN], so + cbo); }
            const f32x4 w0a = gld<f32x4>(cw, ca), w1a = gld<f32x4>(cw, ca + DUP * 4u), w2a = gld<f32x4>(cw, ca + 2u * DUP * 4u), ba = gld<f32x4>(cb, ca);
            const f32x4 w0b = gld<f32x4>(cw, cbo), w1b = gld<f32x4>(cw, cbo + DUP * 4u), w2b = gld<f32x4>(cw, cbo + 2u * DUP * 4u), bbv = gld<f32x4>(cb, cbo);
#pragma unroll
            for (int i = 0; i < 4; ++i) {
                const float a1 = dppf<DPP_SHR(1)>(dppf<DPP_ROR(1)>(0.f, pa[i]), ua[i]), a2 = dppf<DPP_SHR(2)>(dppf<DPP_ROR(2)>(0.f, pa[i]), ua[i]);
                const float b1 = dppf<DPP_SHR(1)>(dppf<DPP_ROR(1)>(0.f, pb[i]), ub[i]), b2 = dppf<DPP_SHR(2)>(dppf<DPP_ROR(2)>(0.f, pb[i]), ub[i]);
                const float prea = ba[i] + w2a[i] * ua[i] + w1a[i] * a1 + w0a[i] * a2, preb = bbv[i] + w2b[i] * ub[i] + w1b[i] * b1 + w0b[i] * b2;
                outv[4 * n + i] = gelu_tanh(prea) * preb;
            }
            if (fr >= 14) {
                float* dst = gI == 0 ? TAILM + (size_t)(fr - 14) * DUP : F.out + O_SF + (size_t)((gI - 1) * 2 + (fr - 14)) * DUP;
                gst<f32x4>(dst, ca) = ua; gst<f32x4>(dst, cbo) = ub;
            }
        }
        gst<u32x4>(ACT, (row * DFF + colbase) * 2u) = pack8(outv);
    }
}
__device__ __forceinline__ void x7_extras(Frame& F) {
    const int lane = lane_asm(), fr = lane & 15, fq = lane >> 4;
    unsigned char* ws = F.ws;
    const bf16_t* ACT = (const bf16_t*)(ws + WS_ACT); const bf16_t* WDN = (const bf16_t*)(ws + WS_WDN);
    float* X1 = (float*)(ws + WS_X1); float* SS2X = (float*)(ws + WS_SS2X);
    for (int it = F.wave * F.G + (int)blockIdx.x; it < NXG * 32; it += F.NGW) {
        const int gI = it >> 5, cg = it & 31; const unsigned row = XROW0 + 16 * gI + fr;
        const unsigned aoff = (row * DFF + 8u * fq) * 2u; unsigned boff[2];
#pragma unroll
        for (int n = 0; n < 2; ++n) boff[n] = ((32u * cg + 8u * (fr >> 2) + 4u * n + (fr & 3)) * DFF + 8u * fq) * 2u;
        f32x4 acc[2] = {(f32x4){0.f, 0.f, 0.f, 0.f}, (f32x4){0.f, 0.f, 0.f, 0.f}};
        mini_mma<2>(ACT, aoff, WDN, boff, 0, 96, acc);
        const unsigned xo = (row * D + 32u * cg + 8u * fq) * 4u;
        const f32x4 v0 = acc[0] + gld<f32x4>(X1, xo), v1 = acc[1] + gld<f32x4>(X1, xo + 16u);
        gst<f32x4>(X1, xo) = v0; gst<f32x4>(X1, xo + 16u) = v1;
        float ss = (v0[0] * v0[0] + v0[1] * v0[1]) + (v0[2] * v0[2] + v0[3] * v0[3]) + (v1[0] * v1[0] + v1[1] * v1[1]) + (v1[2] * v1[2] + v1[3] * v1[3]);
        ss += __shfl_xor(ss, 16); ss += __shfl_xor(ss, 32);
        if (fq == 0) SS2X[(16 * gI + fr) * 32 + cg] = ss;
    }
}

__device__ __forceinline__ void p0_tr_item(const float* W, int ldw, int src_col0, int k0, bf16_t* WT, int ldt, int dst_row0, const float* kscale, LAS float* scr, int lane) {
    float v[32];
#pragma unroll
    for (int i = 0; i < 32; ++i) { const int kk = 2 * i + (lane >> 5); v[i] = W[(size_t)(k0 + kk) * ldw + src_col0 + (lane & 31)]; }
#pragma unroll
    for (int i = 0; i < 32; ++i) { const int kk = 2 * i + (lane >> 5); const float sc = kscale ? kscale[k0 + kk] : 1.0f; scr[kk * 33 + (lane & 31)] = v[i] * sc; }
    LDS_WAIT(); asm volatile("" ::: "memory");
    const int c = lane & 7;
#pragma unroll
    for (int j = 0; j < 4; ++j) { const int n = (lane >> 3) + 8 * j; const LAS float* s = scr + (8 * c) * 33 + n;
        u32x4 o; o.x = pk2(s[0 * 33], s[1 * 33]); o.y = pk2(s[2 * 33], s[3 * 33]); o.z = pk2(s[4 * 33], s[5 * 33]); o.w = pk2(s[6 * 33], s[7 * 33]);
        *(u32x4*)(WT + (size_t)(dst_row0 + n) * ldt + k0 + 8 * c) = o; }
    LDS_WAIT(); asm volatile("" ::: "memory");
}
__device__ __forceinline__ void p0_prologue(Frame& F) {
    const int lane = lane_asm();
    LAS float* scr = (LAS float*)(F.lds + F.wave * 16384);
    unsigned char* ws = F.ws;
    bf16_t* WIN = (bf16_t*)(ws + WS_WIN); bf16_t* WOUT = (bf16_t*)(ws + WS_WOUT); bf16_t* WUP = (bf16_t*)(ws + WS_WUP); bf16_t* WDN = (bf16_t*)(ws + WS_WDN);
    bf16_t* WA = (bf16_t*)(ws + WS_WA); bf16_t* WX = (bf16_t*)(ws + WS_WX); bf16_t* PW = (bf16_t*)(ws + WS_PW);
    bf16_t* XN0 = (bf16_t*)(ws + WS_XN0);
    for (int m2 = F.gw; m2 < MPAD / 2; m2 += F.NGW) {
        const float* xr0 = xrow_ptr(F.in[I_XP], F.in[I_XS], F.in[I_META], 2 * m2); const float* xr1 = xrow_ptr(F.in[I_XP], F.in[I_XS], F.in[I_META], 2 * m2 + 1);
        f32x4 v[2][4];
#pragma unroll
        for (int j = 0; j < 4; ++j) { v[0][j] = xr0 ? ((const f32x4*)xr0)[lane + 64 * j] : (f32x4){0.f, 0.f, 0.f, 0.f}; v[1][j] = xr1 ? ((const f32x4*)xr1)[lane + 64 * j] : (f32x4){0.f, 0.f, 0.f, 0.f}; }
#pragma unroll
        for (int q = 0; q < 2; ++q) {
            float s = 0.f;
#pragma unroll
            for (int j = 0; j < 4; ++j) s += (v[q][j].x * v[q][j].x + v[q][j].y * v[q][j].y) + (v[q][j].z * v[q][j].z + v[q][j].w * v[q][j].w);
            const float rs = 1.0f / sqrtf(wave_sum(s) * (1.0f / D) + EPS);
            unsigned long long* o8 = (unsigned long long*)(XN0 + (size_t)(2 * m2 + q) * D) + lane;
#pragma unroll
            for (int j = 0; j < 4; ++j) o8[64 * j] = (unsigned long long)pk2(v[q][j].x * rs, v[q][j].y * rs) | ((unsigned long long)pk2(v[q][j].z * rs, v[q][j].w * rs) << 32);
        }
    }
    constexpr int I_IN = (D / 64) * (DIN / 32), I_OUT = (D / 64) * (D / 32), I_UP = (D / 64) * (DUP / 32), I_DN = (DFF / 64) * (D / 32), I_GA = 8 * 2, I_PWI = 4 * 2 * 4;
    constexpr int NITEMS = I_IN + I_OUT + I_UP + I_DN + 2 * I_GA + I_PWI;
    for (int it = F.gw; it < NITEMS; it += F.NGW) {
        int r = it;
        if (r < I_IN) { const int nb = DIN / 32, kb = r / nb, n0 = 32 * (r % nb); p0_tr_item(F.in[I_WIN], DIN, n0, 64 * kb, WIN, D, n0, F.in[I_GMIX], scr, lane); continue; } r -= I_IN;
        if (r < I_OUT) { const int nb = D / 32, kb = r / nb, n0 = 32 * (r % nb); const int k0 = 64 * kb;
            p0_tr_item(F.in[I_WOUT], D, n0, k0, WOUT, D, n0, k0 < DLRU ? F.in[I_GNL] : F.in[I_GNP] - DLRU, scr, lane); continue; } r -= I_OUT;
        if (r < I_UP) { const int nb = DUP / 32, kb = r / nb, n0 = 32 * (r % nb);
            const int pn = n0 >> 8, bj = (n0 >> 7) & 1, q = n0 & 127; p0_tr_item(F.in[I_WUP], DUP, DFF * bj + 128 * pn + q, 64 * kb, WUP, D, n0, F.in[I_GFFN], scr, lane); continue; } r -= I_UP;
        if (r < I_DN) { const int nb = D / 32, kb = r / nb, n0 = 32 * (r % nb); p0_tr_item(F.in[I_WDN], D, n0, 64 * kb, WDN, DFF, n0, nullptr, scr, lane); continue; } r -= I_DN;
        if (r < I_GA) { const int h = r >> 1, n0 = 32 * (r & 1); p0_tr_item(F.in[I_GAW] + h * 4096, 64, n0, 0, WA + h * 4096, 64, n0, nullptr, scr, lane); continue; } r -= I_GA;
        if (r < I_GA) { const int h = r >> 1, n0 = 32 * (r & 1); p0_tr_item(F.in[I_GXW] + h * 4096, 64, n0, 0, WX + h * 4096, 64, n0, nullptr, scr, lane); continue; } r -= I_GA;
        { const int g = r >> 3, kb = (r >> 2) & 1, n0 = 32 * (r & 3); p0_tr_item(F.in[I_PW] + g * 16384, 128, n0, 64 * kb, PW + g * 16384, 128, n0, nullptr, scr, lane); }
    }
    bf16_t* U = (bf16_t*)(ws + WS_U);
    for (int e = F.gw * 64 + lane; e < 9 * 16 * DIN; e += F.NGW * 64) {
        const int hr = e / DIN, col = e % DIN, sid = hr >> 4, k = hr & 15; float v = 0.f;
        if (sid > 0) { const int b = sid - 1;
            if (col < DLRU) { if (k >= 13) v = F.in[I_SLC][((size_t)b * 3 + (k - 13)) * DLRU + col]; }
            else if (col >= 2 * DLRU) { if (k >= 1) v = F.in[I_SPOOL][((size_t)b * 15 + (k - 1)) * 512 + (col - 2 * DLRU)]; } }
        U[(size_t)(MPAD + hr) * DIN + col] = (bf16_t)f2bf(v);
    }
    float* LSL = (float*)(ws + WS_LSL);
    for (int e = F.gw * 64 + lane; e < DLRU; e += F.NGW * 64) { const float x = F.in[I_LAM][e]; LSL[e] = -8.0f * (fmaxf(-x, 0.f) + log1pf(expf(-fabsf(x)))); }
}

constexpr int CST_CW = 0, CST_CB = 2048, CST_GAB = 2560, CST_GXB = 3072, CST_LSL = 3584, CST_PB = 4096, CST_PS = 4608, CST_N = 5120, SSQL_OFF = 5120, SSQP_OFF = 5120 + 640;
constexpr int GW_OFF = 25600;
static_assert(GW_OFF + 131072 <= MISC_OFF, "P2/P3 LDS map");
__device__ __forceinline__ void p23_weights(Frame& F, int tid, const void* src) {
    const u32x4* gsrc = (const u32x4*)src; LAS u32x4* gdst = (LAS u32x4*)(F.lds + GW_OFF);
#pragma unroll 4
    for (int i = tid; i < 131072 / 16; i += NWAVES * 64) gdst[i] = gsrc[i];
}
__device__ __forceinline__ void p23_consts(Frame& F, int tid) {
    LAS float* cst = (LAS float*)F.lds;
    const float* LSL = (const float*)(F.ws + WS_LSL);
    for (int i = tid; i < CST_N; i += NWAVES * 64) {
        float v;
        if (i < CST_CB) v = F.in[I_CLW][i]; else if (i < CST_GAB) v = F.in[I_CLB][i - CST_CB]; else if (i < CST_GXB) v = F.in[I_GAB][i - CST_GAB];
        else if (i < CST_LSL) v = F.in[I_GXB][i - CST_GXB]; else if (i < CST_PB) v = LSL[i - CST_LSL]; else if (i < CST_PS) v = F.in[I_PB][i - CST_PB]; else v = F.in[I_PS][i - CST_PS];
        cst[i] = v;
    }
}
__device__ __forceinline__ unsigned blk_row0(bool prompt, int bg, int sb) {
    if (prompt) return bg < 0 ? (unsigned)MPAD : (bg == 0 ? (unsigned)XROW0 : 16u * (unsigned)(bg - 1));
    return bg < 0 ? (unsigned)(MPAD + 16 * (1 + sb)) : (unsigned)(TP + 16 * sb);
}
template <bool FINAL>
__device__ __forceinline__ void lru_pass(Frame& F, LAS const float* cst, LAS float* ssqL, bool prompt, int sb, int bg0, int nblk, int lane, float (&hprev)[2][8], float (&pprev)[2][8]) {
    const int w = F.wave, fr = lane & 15, fq = lane >> 4;
    unsigned char* ws = F.ws;
    const bf16_t* U = (const bf16_t*)(ws + WS_U); bf16_t* Z = (bf16_t*)(ws + WS_Z);
    const unsigned chl = 64u * w + 8u * fq, sigl = 8u * (fr >> 2) + (fr & 3);
    const unsigned wg_off = GW_OFF + ((64u * w + sigl) * 64u + 8u * fq) * 2u;
    unsigned ucol = chl * 2u; asm volatile("" : "+v"(ucol));
    u32x4 xp[2], xc[2], xn[2], gc[2], gn[2];
    { const unsigned r = (blk_row0(prompt, bg0 - 1, sb) + fr) * (DIN * 2u) + ucol; xp[0] = gld<u32x4>(U, r); xp[1] = gld<u32x4>(U, r + 64u); }
    { const unsigned r = (blk_row0(prompt, bg0, sb) + fr) * (DIN * 2u) + ucol; xc[0] = gld<u32x4>(U, r); xc[1] = gld<u32x4>(U, r + 64u);
      if (FINAL) { gc[0] = gld<u32x4>(U, r + DLRU * 2u); gc[1] = gld<u32x4>(U, r + DLRU * 2u + 64u); } }
    xn[0] = xc[0]; xn[1] = xc[1]; if (FINAL) { gn[0] = gc[0]; gn[1] = gc[1]; }
#pragma unroll 1
    for (int b = 0; b < nblk; ++b) {
        const unsigned row = blk_row0(prompt, bg0 + b, sb) + fr;
        if (b + 1 < nblk) { const unsigned r = (blk_row0(prompt, bg0 + b + 1, sb) + fr) * (DIN * 2u) + ucol; xn[0] = gld<u32x4>(U, r); xn[1] = gld<u32x4>(U, r + 64u);
            if (FINAL) { gn[0] = gld<u32x4>(U, r + DLRU * 2u); gn[1] = gld<u32x4>(U, r + DLRU * 2u + 64u); } }
        unsigned lz = 0; asm volatile("" : "+v"(lz));
        float c[2][8]; bf16x8 cbf[2];
#pragma unroll
        for (int s = 0; s < 2; ++s) {
            LAS const float* cc = cst + chl + 32 * s + lz;
            float x3[8], x2[8], x1[8], x0[8];
            unpack8(xc[s], x3); unpack8(shift_tok<1>(xp[s], xc[s]), x2); unpack8(shift_tok<2>(xp[s], xc[s]), x1); unpack8(shift_tok<3>(xp[s], xc[s]), x0);
#pragma unroll
            for (int h4 = 0; h4 < 2; ++h4) {
                const f32x4 bv = *(LAS const f32x4*)(cc + CST_CB + 4 * h4), w0 = *(LAS const f32x4*)(cc + CST_CW + 4 * h4), w1 = *(LAS const f32x4*)(cc + CST_CW + 512 + 4 * h4),
                            w2 = *(LAS const f32x4*)(cc + CST_CW + 1024 + 4 * h4), w3 = *(LAS const f32x4*)(cc + CST_CW + 1536 + 4 * h4);
#pragma unroll
                for (int i = 0; i < 4; ++i) { const int j = 4 * h4 + i; c[s][j] = bv[i] + w3[i] * x3[j] + w2[i] * x2[j] + w1[i] * x1[j] + w0[i] * x0[j]; }
            }
            const u32x4 pk = pack8(c[s]); cbf[s] = __builtin_bit_cast(bf16x8, pk);
        }
        f32x4 ra[4], ia[4];
#pragma unroll
        for (int n = 0; n < 4; ++n) { ra[n] = (f32x4){0.f, 0.f, 0.f, 0.f}; ia[n] = ra[n]; }
#pragma unroll
        for (int n = 0; n < 4; ++n)
#pragma unroll
            for (int s = 0; s < 2; ++s) {
                const unsigned o = wg_off + lz + (32u * (n >> 1) + 4u * (n & 1)) * 128u + 64u * s;
                const bf16x8 wa = *(LAS const bf16x8*)(F.lds + o), wx = *(LAS const bf16x8*)(F.lds + o + 65536u);
                ra[n] = __builtin_amdgcn_mfma_f32_16x16x32_bf16(wa, cbf[s], ra[n], 0, 0, 0);
                ia[n] = __builtin_amdgcn_mfma_f32_16x16x32_bf16(wx, cbf[s], ia[n], 0, 0, 0);
            }
#pragma unroll
        for (int s = 0; s < 2; ++s) {
            LAS const float* cc = cst + chl + 32 * s + lz;
#pragma unroll
            for (int h4 = 0; h4 < 2; ++h4) {
                const f32x4 gab = *(LAS const f32x4*)(cc + CST_GAB + 4 * h4), gxb = *(LAS const f32x4*)(cc + CST_GXB + 4 * h4), lsl = *(LAS const f32x4*)(cc + CST_LSL + 4 * h4);
#pragma unroll
                for (int i = 0; i < 4; ++i) {
                    const int j = 4 * h4 + i, n = 2 * s + h4;
                    const float r = fast_sigmoid(ra[n][i] + gab[i]), ig = fast_sigmoid(ia[n][i] + gxb[i]);
                    const float la = r * lsl[i];
                    float a = __builtin_amdgcn_exp2f(la * 1.4426950408889634f);
                    const float x2v = la + la;
                    const float poly = -x2v * (1.f + x2v * 0.5f * (1.f + x2v * (1.f / 3.f) * (1.f + x2v * 0.25f * (1.f + x2v * 0.2f * (1.f + x2v * (1.f / 6.f))))));
                    const float om = x2v > -0.25f ? poly : 1.0f - a * a;
                    float v = __builtin_amdgcn_sqrtf(om) * (ig * c[s][j]);
                    const float ph = dppf<DPP_ROR(1)>(0.f, hprev[s][j]);
                    if (!FINAL) { const float pp = dppf<DPP_ROR(1)>(0.f, pprev[s][j]); if (fr == 0) { v = a * ph + v; a = a * pp; } }
                    else { if (fr == 0) v = a * ph + v; }
                    { const float vp = dppf<DPP_SHR(1)>(0.f, v), ap = dppf<DPP_SHR(1)>(1.f, a); v = a * vp + v; a = a * ap; }
                    { const float vp = dppf<DPP_SHR(2)>(0.f, v), ap = dppf<DPP_SHR(2)>(1.f, a); v = a * vp + v; a = a * ap; }
                    { const float vp = dppf<DPP_SHR(4)>(0.f, v), ap = dppf<DPP_SHR(4)>(1.f, a); v = a * vp + v; a = a * ap; }
                    { const float vp = dppf<DPP_SHR(8)>(0.f, v), ap = dppf<DPP_SHR(8)>(1.f, a); v = a * vp + v; a = a * ap; }
                    hprev[s][j] = v; pprev[s][j] = a;
                }
                if (2 * s + h4 < 3) asm volatile("" : "+v"(ra[2 * s + h4 + 1]), "+v"(ia[2 * s + h4 + 1]) : "v"(hprev[s][4 * h4 + 3]));
            }
        }
        if (FINAL) {
            float ssl = 0.f;
#pragma unroll
            for (int s = 0; s < 2; ++s) {
                float gx[8], y[8]; unpack8(gc[s], gx);
#pragma unroll
                for (int j = 0; j < 8; ++j) { y[j] = hprev[s][j] * gelu_tanh(gx[j]); ssl += y[j] * y[j]; }
                gst<u32x4>(Z, row * (D * 2u) + chl * 2u + 64u * s) = pack8(y);
            }
            ssl += __shfl_xor(ssl, 16); ssl += __shfl_xor(ssl, 32);
            if (fq == 0) ssqL[(16 * b + fr) * 8 + w] = ssl;
        }
        xp[0] = xc[0]; xp[1] = xc[1]; xc[0] = xn[0]; xc[1] = xn[1];
        if (FINAL) { gc[0] = gn[0]; gc[1] = gn[1]; }
    }
}
template <int PG>
__device__ __forceinline__ void pool_pass(Frame& F, LAS const float* cst, LAS float* ssqP, bool prompt, int sb, int bg0, int nblk, int lane) {
    const int w = F.wave, fr = lane & 15, fq = lane >> 4;
    unsigned char* ws = F.ws;
    const bf16_t* U = (const bf16_t*)(ws + WS_U); bf16_t* Z = (bf16_t*)(ws + WS_Z);
    constexpr unsigned g = PG; const unsigned half = w & 1, sigl = 8u * (fr >> 2) + (fr & 3);
    const unsigned pw_off = GW_OFF + ((128u * g + 64u * half + sigl) * 128u + 8u * fq) * 2u;
    unsigned pcol = (2u * DLRU + 128u * g + 8u * fq) * 2u; asm volatile("" : "+v"(pcol));
    float csprev[4][8];
    { const unsigned r = (blk_row0(prompt, bg0 - 1, sb) + fr) * (DIN * 2u) + pcol;
#pragma unroll
      for (int s = 0; s < 4; ++s) { float x[8]; unpack8(gld<u32x4>(U, r + 64u * s), x);
#pragma unroll
        for (int j = 0; j < 8; ++j) { float cs = x[j];
            cs += dppf<DPP_SHR(1)>(0.f, cs); cs += dppf<DPP_SHR(2)>(0.f, cs); cs += dppf<DPP_SHR(4)>(0.f, cs); cs += dppf<DPP_SHR(8)>(0.f, cs);
            csprev[s][j] = cs; } } }
    u32x4 pc[4], pn[4];
    { const unsigned r = (blk_row0(prompt, bg0, sb) + fr) * (DIN * 2u) + pcol;
#pragma unroll
      for (int s = 0; s < 4; ++s) { pc[s] = gld<u32x4>(U, r + 64u * s); pn[s] = pc[s]; } }
    constexpr int wl = 2 << PG;
#pragma unroll 1
    for (int b = 0; b < nblk; ++b) {
        const unsigned row = blk_row0(prompt, bg0 + b, sb) + fr;
        if (b + 1 < nblk) { const unsigned r = (blk_row0(prompt, bg0 + b + 1, sb) + fr) * (DIN * 2u) + pcol;
#pragma unroll
            for (int s = 0; s < 4; ++s) pn[s] = gld<u32x4>(U, r + 64u * s); }
        const int pos = prompt ? 16 * (bg0 + b) + fr : 1024 + fr;
        const float invc = 1.0f / (float)(pos + 1 < wl ? pos + 1 : wl);
        bf16x8 mb[4];
#pragma unroll
        for (int s = 0; s < 4; ++s) {
            float x[8], m8[8]; unpack8(pc[s], x);
#pragma unroll
            for (int j = 0; j < 8; ++j) {
                const float cp = csprev[s][j];
                float cs = x[j]; const float t0 = dppf<DPP_ROR(1)>(0.f, cp); if (fr == 0) cs += t0;
                cs += dppf<DPP_SHR(1)>(0.f, cs); cs += dppf<DPP_SHR(2)>(0.f, cs); cs += dppf<DPP_SHR(4)>(0.f, cs); cs += dppf<DPP_SHR(8)>(0.f, cs);
                float sh;
                if constexpr (PG == 3) sh = cp; else sh = dppf<DPP_SHR(wl)>(dppf<DPP_ROR(wl)>(0.f, cp), cs);
                m8[j] = (cs - sh) * invc - x[j];
                csprev[s][j] = cs;
            }
            const u32x4 pk = pack8(m8); mb[s] = __builtin_bit_cast(bf16x8, pk);
        }
        f32x4 pacc[4];
#pragma unroll
        for (int n = 0; n < 4; ++n) pacc[n] = (f32x4){0.f, 0.f, 0.f, 0.f};
        unsigned dch0 = 0; asm volatile("" : "+v"(dch0));
#pragma unroll
        for (int n = 0; n < 4; ++n)
#pragma unroll
            for (int s = 0; s < 4; ++s) { const bf16x8 pwf = *(LAS const bf16x8*)(F.lds + pw_off + dch0 + (32u * (n >> 1) + 4u * (n & 1)) * 256u + 64u * s);
                pacc[n] = __builtin_amdgcn_mfma_f32_16x16x32_bf16(pwf, mb[s], pacc[n], 0, 0, 0); }
        float ssp = 0.f;
        unsigned dch = 128u * g + 64u * half + 8u * fq; asm volatile("" : "+v"(dch));
#pragma unroll
        for (int p = 0; p < 2; ++p) {
            float y[8];
#pragma unroll
            for (int h4 = 0; h4 < 2; ++h4) {
                const f32x4 bv = *(LAS const f32x4*)(cst + CST_PB + dch + 32 * p + 4 * h4), sv = *(LAS const f32x4*)(cst + CST_PS + dch + 32 * p + 4 * h4);
#pragma unroll
                for (int i = 0; i < 4; ++i) { const float t = (pacc[2 * p + h4][i] + bv[i]) * sv[i]; y[4 * h4 + i] = t; ssp += t * t; }
            }
            gst<u32x4>(Z, row * (D * 2u) + (DLRU + dch) * 2u + 64u * p) = pack8(y);
        }
        ssp += __shfl_xor(ssp, 16); ssp += __shfl_xor(ssp, 32);
        if (fq == 0) ssqP[(16 * b + fr) * 8 + w] = ssp;
#pragma unroll
        for (int s = 0; s < 4; ++s) pc[s] = pn[s];
    }
}
template <bool FINAL>
__device__ __forceinline__ void p2_phase(Frame& F) {
    const int w = F.wave;
    unsigned char* ws = F.ws;
    float* AGGA = (float*)(ws + WS_AGGA); float* AGGH = (float*)(ws + WS_AGGH);
    LAS float* cst = (LAS float*)F.lds; LAS float* ssqL = cst + SSQL_OFF; LAS float* ssqP = cst + SSQP_OFF;
    p23_consts(F, w * 64 + lane_asm());
    bool gates_in = false;
    for (int item = blockIdx.x; item < NITEM2; item += F.G) {
        const int lane = lane_asm(), fr = lane & 15, fq = lane >> 4, tid = w * 64 + lane;
        const unsigned chl = 64u * w + 8u * fq;
        const bool prompt = item < NCHUNK_P;
        if (!FINAL && !prompt) continue;
        if (!gates_in) { p23_weights(F, tid, F.ws + WS_WA); gates_in = true; WG_BARRIER(); }
        const int sb = prompt ? 0 : item - NCHUNK_P, bg0 = prompt ? 5 * item : 0, nblk = prompt ? 5 : 1;
        float hprev[2][8], pprev[2][8];
#pragma unroll
        for (int s = 0; s < 2; ++s)
#pragma unroll
            for (int j = 0; j < 8; ++j) { hprev[s][j] = 0.f; pprev[s][j] = 1.f; }
        if (FINAL) {
            if (prompt) {
                float fa[2][8];
#pragma unroll
                for (int s = 0; s < 2; ++s)
#pragma unroll
                    for (int j = 0; j < 8; ++j) fa[s][j] = 1.f;
                const int q0 = 13 * fr, q1 = (q0 + 13 < item) ? q0 + 13 : item;
                unsigned cho4 = chl * 4u; asm volatile("" : "+v"(cho4));
#pragma unroll 2
                for (int q = q0; q < q1; ++q) {
                    const unsigned ao = (unsigned)q * (DLRU * 4u) + cho4;
#pragma unroll
                    for (int s = 0; s < 2; ++s) {
                        const f32x4 a0 = gld<f32x4>(AGGA, ao + 128u * s), a1 = gld<f32x4>(AGGA, ao + 128u * s + 16u), h0 = gld<f32x4>(AGGH, ao + 128u * s), h1 = gld<f32x4>(AGGH, ao + 128u * s + 16u);
#pragma unroll
                        for (int j = 0; j < 4; ++j) { hprev[s][j] = a0[j] * hprev[s][j] + h0[j]; fa[s][j] *= a0[j]; hprev[s][4 + j] = a1[j] * hprev[s][4 + j] + h1[j]; fa[s][4 + j] *= a1[j]; }
                    }
                }
#pragma unroll
                for (int s = 0; s < 2; ++s)
#pragma unroll
                    for (int j = 0; j < 8; ++j) { float a = fa[s][j], v = hprev[s][j];
                        { const float vp = dppf<DPP_SHR(1)>(0.f, v), ap = dppf<DPP_SHR(1)>(1.f, a); v = a * vp + v; a = a * ap; }
                        { const float vp = dppf<DPP_SHR(2)>(0.f, v), ap = dppf<DPP_SHR(2)>(1.f, a); v = a * vp + v; a = a * ap; }
                        { const float vp = dppf<DPP_SHR(4)>(0.f, v), ap = dppf<DPP_SHR(4)>(1.f, a); v = a * vp + v; a = a * ap; }
                        { const float vp = dppf<DPP_SHR(8)>(0.f, v), ap = dppf<DPP_SHR(8)>(1.f, a); v = a * vp + v; a = a * ap; }
                        hprev[s][j] = v; }
            } else {
                const unsigned ho = ((unsigned)sb * DLRU + chl) * 4u;
#pragma unroll
                for (int s = 0; s < 2; ++s) { const f32x4 a0 = gld<f32x4>(F.in[I_SLH], ho + 128u * s), a1 = gld<f32x4>(F.in[I_SLH], ho + 128u * s + 16u);
#pragma unroll
                    for (int j = 0; j < 4; ++j) { hprev[s][j] = a0[j]; hprev[s][4 + j] = a1[j]; } }
            }
        }
        lru_pass<FINAL>(F, cst, ssqL, prompt, sb, bg0, nblk, lane, hprev, pprev);
        if (!FINAL) {
            if (fr == 15) {
                const unsigned ao = ((unsigned)item * DLRU + chl) * 4u;
#pragma unroll
                for (int s = 0; s < 2; ++s) {
                    gst<f32x4>(AGGA, ao + 128u * s) = (f32x4){pprev[s][0], pprev[s][1], pprev[s][2], pprev[s][3]}; gst<f32x4>(AGGA, ao + 128u * s + 16u) = (f32x4){pprev[s][4], pprev[s][5], pprev[s][6], pprev[s][7]};
                    gst<f32x4>(AGGH, ao + 128u * s) = (f32x4){hprev[s][0], hprev[s][1], hprev[s][2], hprev[s][3]}; gst<f32x4>(AGGH, ao + 128u * s + 16u) = (f32x4){hprev[s][4], hprev[s][5], hprev[s][6], hprev[s][7]};
                }
            }
            continue;
        }
        const bool lastp = (item == NCHUNK_P - 1);
        if ((lastp || !prompt) && fr == 15) {
            float* oh = F.out + (lastp ? O_PH : O_SH + (size_t)sb * DLRU);
#pragma unroll
            for (int s = 0; s < 2; ++s) { float* p = oh + chl + 32 * s;
                *(f32x4*)p = (f32x4){hprev[s][0], hprev[s][1], hprev[s][2], hprev[s][3]}; *(f32x4*)(p + 4) = (f32x4){hprev[s][4], hprev[s][5], hprev[s][6], hprev[s][7]}; }
        }
        WG_BARRIER();
        p23_weights(F, tid, F.ws + WS_PW); gates_in = false;
        WG_BARRIER();
        switch (w >> 1) { case 0: pool_pass<0>(F, cst, ssqP, prompt, sb, bg0, nblk, lane); break; case 1: pool_pass<1>(F, cst, ssqP, prompt, sb, bg0, nblk, lane); break;
                          case 2: pool_pass<2>(F, cst, ssqP, prompt, sb, bg0, nblk, lane); break; default: pool_pass<3>(F, cst, ssqP, prompt, sb, bg0, nblk, lane); break; }
        WG_BARRIER();
        if (tid < 16 * nblk) {
            const unsigned row = blk_row0(prompt, bg0 + (tid >> 4), sb) + (tid & 15);
            const f32x4 l0 = *(LAS const f32x4*)(ssqL + tid * 8), l1 = *(LAS const f32x4*)(ssqL + tid * 8 + 4), p0 = *(LAS const f32x4*)(ssqP + tid * 8), p1 = *(LAS const f32x4*)(ssqP + tid * 8 + 4);
            ((float*)(ws + WS_RSL))[row] = __builtin_amdgcn_rsqf((((l0[0] + l0[1]) + (l0[2] + l0[3])) + ((l1[0] + l1[1]) + (l1[2] + l1[3]))) * (1.0f / 512.f) + EPS);
            ((float*)(ws + WS_RSP))[row] = __builtin_amdgcn_rsqf((((p0[0] + p0[1]) + (p0[2] + p0[3])) + ((p1[0] + p1[1]) + (p1[2] + p1[3]))) * (1.0f / 512.f) + EPS);
        }
        if (lastp || !prompt) {
            const bf16_t* U = (const bf16_t*)(ws + WS_U);
            const int last_row = lastp ? MMAIN - 1 : TP + 16 * sb + 15;
            float* oc = F.out + (lastp ? O_PC : O_SC + (size_t)sb * 3 * DLRU);
            float* op = F.out + (lastp ? O_PP : O_SP + (size_t)sb * 15 * 512);
            for (int e = tid; e < 3 * DLRU; e += NWAVES * 64) { const int k = e / DLRU, ch = e % DLRU; oc[e] = bflo((unsigned)U[(size_t)(last_row - 2 + k) * DIN + ch]); }
            for (int e = tid; e < 15 * 512; e += NWAVES * 64) { const int k = e / 512, ch = e % 512; op[e] = bflo((unsigned)U[(size_t)(last_row - 14 + k) * DIN + 2 * DLRU + ch]); }
        }
        WG_BARRIER();
    }
}

__device__ __forceinline__ void p6_fixup(Frame& F) {
    const int lane = lane_asm();
    unsigned char* ws = F.ws;
    const float* HEAD = (const float*)(ws + WS_HEAD); const float* TAIL = (const float*)(ws + WS_TAIL); const float* TAILM = (const float*)(ws + WS_TAILM);
    bf16_t* ACT = (bf16_t*)(ws + WS_ACT);
    const float* cw = F.in[I_FCW]; const float* cb = F.in[I_FCB];
    constexpr int NIT = 64, NJ4 = DFF / 4;
    for (int e = F.gw * 64 + lane; e < NIT * NJ4; e += F.NGW * 64) {
        const int it = e / NJ4, j = 4 * (e % NJ4);
        const float* c0 = HEAD + (size_t)(it * 2) * DUP; const float* c1 = c0 + DUP;
        const float* p0 = it == 0 ? TAILM : TAIL + (size_t)((it - 1) * 2) * DUP; const float* p1 = p0 + DUP;
        const int row0 = it * 256;
        f32x4 o0, o1; float pre0[2][4], pre1[2][4];
#pragma unroll
        for (int bj = 0; bj < 2; ++bj) {
            const int c = bj * DFF + j;
            const f32x4 w0 = *(const f32x4*)(cw + c), w1 = *(const f32x4*)(cw + DUP + c), w2 = *(const f32x4*)(cw + 2 * DUP + c), bb = *(const f32x4*)(cb + c);
            const f32x4 x0 = *(const f32x4*)(c0 + c), x1 = *(const f32x4*)(c1 + c), q0 = *(const f32x4*)(p0 + c), q1 = *(const f32x4*)(p1 + c);
#pragma unroll
            for (int i = 0; i < 4; ++i) { pre0[bj][i] = bb[i] + w2[i] * x0[i] + w1[i] * q1[i] + w0[i] * q0[i]; pre1[bj][i] = bb[i] + w2[i] * x1[i] + w1[i] * x0[i] + w0[i] * q1[i]; }
        }
#pragma unroll
        for (int i = 0; i < 4; ++i) { o0[i] = gelu_tanh(pre0[0][i]) * pre0[1][i]; o1[i] = gelu_tanh(pre1[0][i]) * pre1[1][i]; }
        u32x2 w0p, w1p; w0p.x = pk2(o0[0], o0[1]); w0p.y = pk2(o0[2], o0[3]); w1p.x = pk2(o1[0], o1[1]); w1p.y = pk2(o1[2], o1[3]);
        *(u32x2*)(ACT + (size_t)row0 * DFF + j) = w0p; *(u32x2*)(ACT + (size_t)(row0 + 1) * DFF + j) = w1p;
    }
    for (int e = F.gw * 64 + lane; e < 2 * DUP; e += F.NGW * 64) F.out[O_PF + e] = TAIL[(size_t)(63 * 2) * DUP + e];
}
__device__ __forceinline__ void p8_final(Frame& F) {
    const int lane = lane_asm();
    const float* X2 = (const float*)(F.ws + WS_X1); const float* SS2 = (const float*)(F.ws + WS_SS2); const float* SS2X = (const float*)(F.ws + WS_SS2X); const float* gf = F.in[I_GFIN];
    for (int m = F.gw; m < MMAIN + 128; m += F.NGW) {
        const int row = m < MMAIN ? m : TP + (m - MMAIN);
        float* o = m < MMAIN ? F.out + O_YP + (size_t)m * D : F.out + O_YS + (size_t)(m - MMAIN) * D;
        float tot;
        if (m < MMAIN) { const f32x4 s = *(const f32x4*)(SS2 + (size_t)row * 4); tot = (s[0] + s[1]) + (s[2] + s[3]); }
        else { const float* p = SS2X + (size_t)(row - XROW0) * 32; f32x4 s = *(const f32x4*)p;
#pragma unroll
            for (int q = 1; q < 8; ++q) s = s + *(const f32x4*)(p + 4 * q);
            tot = (s[0] + s[1]) + (s[2] + s[3]); }
        const float rs = 1.0f / sqrtf(tot * (1.0f / D) + EPS);
        const f32x4* x4 = (const f32x4*)(X2 + (size_t)row * D) + lane; const f32x4* g4 = (const f32x4*)gf + lane; f32x4* o4 = (f32x4*)o + lane;
#pragma unroll
        for (int j = 0; j < 4; ++j) o4[64 * j] = x4[64 * j] * rs * g4[64 * j];
    }
}

template <int LO, int HI>
__device__ __forceinline__ void mk_body(const Args& args, unsigned char* lds_raw) {
    Frame F;
    F.lds = (LAS unsigned char*)lds_raw;
    F.wave = __builtin_amdgcn_readfirstlane((int)threadIdx.x >> 6);
    F.G = gridDim.x; F.gw = blockIdx.x * NWAVES + F.wave; F.NGW = F.G * NWAVES;
    F.in = args.in; F.out = args.out; F.ws = args.ws;
    unsigned char* ws = args.ws;
    if (threadIdx.x < 64) ((LAS unsigned*)(F.lds + MISC_OFF))[threadIdx.x] = 0u;
    __syncthreads();
    XcdBarrier bar; bar.bar = (unsigned*)(ws + WS_CTL) + CW_BAR; bar.x = 0; bar.st = nullptr;
    if (LO < 0) bar = xcd_barrier_post((unsigned*)(ws + WS_CTL) + CW_BAR, (volatile LAS unsigned*)(F.lds + MISC_OFF) + 8, threadIdx.x == 0);
    const int lo = LO < 0 ? args.ph_lo : LO, hi = LO < 0 ? args.ph_hi : HI;
#ifndef PHASE_MASK
#define PHASE_MASK 0x1ff
#endif
#define IN(k) (((PHASE_MASK >> (k)) & 1) && lo <= (k) && (k) < hi)
#define SEAM(k) do { if (IN(k) && IN((k) + 1)) xcd_barrier(bar, F.wave); } while (0)
    if (IN(0)) { p0_prologue(F); } SEAM(0);
    if (IN(1)) {
        pg8::Gemm g{(const bf16_t*)(ws + WS_XN0), (const bf16_t*)(ws + WS_WIN), MPAD, DIN, D}; pg8::StaticOrder S; S.init(MPAD, DIN, F.G, (int)blockIdx.x);
        pg8::EpiBf16 E{(bf16_t*)(ws + WS_U), DIN};
        pg8::gemm_phase<pg8::EpiBf16, false>(F.lds, g, S, E, F.wave);
    } SEAM(1);
    if (IN(2)) { p2_phase<false>(F); } SEAM(2);
    if (IN(3)) { p2_phase<true>(F); } SEAM(3);
    if (IN(4)) {
        pg8::Gemm g{(const bf16_t*)(ws + WS_Z), (const bf16_t*)(ws + WS_WOUT), MMAIN, D, D}; pg8::StaticOrder S; S.init(MMAIN, D, F.G, (int)blockIdx.x);
        pg8::EpiResid<true> E{F.in[I_XP], F.in[I_XS], F.in[I_META], (const float*)(ws + WS_RSL), (const float*)(ws + WS_RSP), (float*)(ws + WS_X1), (bf16_t*)(ws + WS_XB1), (float*)(ws + WS_SS1), (LAS float*)(F.lds + BND_OFF)};
        pg8::gemm_phase<pg8::EpiResid<true>, true>(F.lds, g, S, E, F.wave);
        x4_extras(F);
    } SEAM(4);
    if (IN(5)) {
        pg8::Gemm g{(const bf16_t*)(ws + WS_XB1), (const bf16_t*)(ws + WS_WUP), MMAIN, DUP, D}; pg8::StaticOrder S; S.init(MMAIN, DUP, F.G, (int)blockIdx.x);
        pg8::EpiUpGate E{(const float*)(ws + WS_SS1), F.in[I_FCW], F.in[I_FCB], (bf16_t*)(ws + WS_ACT), (float*)(ws + WS_HEAD), (float*)(ws + WS_TAIL), (LAS float*)(F.lds + BND_OFF)};
        pg8::gemm_phase<pg8::EpiUpGate, false>(F.lds, g, S, E, F.wave);
        x5_extras(F);
    } SEAM(5);
    if (IN(6)) { p6_fixup(F); } SEAM(6);
    if (IN(7)) {
        pg8::Gemm g{(const bf16_t*)(ws + WS_ACT), (const bf16_t*)(ws + WS_WDN), MMAIN, D, DFF}; pg8::StaticOrder S; S.init(MMAIN, D, F.G, (int)blockIdx.x);
        pg8::EpiResid<false> E{nullptr, nullptr, nullptr, nullptr, nullptr, (float*)(ws + WS_X1), nullptr, (float*)(ws + WS_SS2), (LAS float*)(F.lds + BND_OFF)};
        pg8::gemm_phase<pg8::EpiResid<false>, false>(F.lds, g, S, E, F.wave);
        x7_extras(F);
    } SEAM(7);
    if (IN(8)) { p8_final(F); }
#undef IN
#undef SEAM
}
#if MK_N_LAUNCHES == 1
__global__ void __launch_bounds__(NWAVES * 64, 2) mk_fwd(Args args) {
    extern __shared__ __attribute__((aligned(16))) unsigned char lds_raw[];
    mk_body<-1, -1>(args, lds_raw);
}
#else
template <int PH> __global__ void __launch_bounds__(NWAVES * 64, 2) mk_ph(Args args) {
    extern __shared__ __attribute__((aligned(16))) unsigned char lds_raw[];
    mk_body<PH, PH + 1>(args, lds_raw);
}
#endif

#if MK_N_LAUNCHES != 1
typedef void (*kern_t)(Args);
static kern_t phase_kernel(int k) {
    switch (k) { case 0: return mk_ph<0>; case 1: return mk_ph<1>; case 2: return mk_ph<2>; case 3: return mk_ph<3>; case 4: return mk_ph<4>;
                 case 5: return mk_ph<5>; case 6: return mk_ph<6>; case 7: return mk_ph<7>; default: return mk_ph<8>; }
}
#endif
extern "C" void kernel_launch(void* const* d_in, const int* in_sizes, int n_in, void* d_out, int out_size, void* d_ws, size_t ws_size, hipStream_t stream) {
    static int grid = 0;
    if (grid == 0) {
        if (n_in != 28 || ws_size < WS_END) { fprintf(stderr, "kernel_launch: built for 28 inputs and >= %zu bytes of workspace; got n_in %d, ws %zu\n", (size_t)WS_END, n_in, ws_size); grid = -1; return; }
        int dev = 0, cus = 0, per_cu = 0;
        if (hipGetDevice(&dev) != hipSuccess || hipDeviceGetAttribute(&cus, hipDeviceAttributeMultiprocessorCount, dev) != hipSuccess) { grid = -1; return; }
#if MK_N_LAUNCHES == 1
        if (hipFuncSetAttribute((const void*)mk_fwd, hipFuncAttributeMaxDynamicSharedMemorySize, LDS_BYTES) != hipSuccess) { fprintf(stderr, "kernel_launch: hipFuncSetAttribute failed\n"); grid = -1; return; }
        if (hipOccupancyMaxActiveBlocksPerMultiprocessor(&per_cu, (const void*)mk_fwd, NWAVES * 64, LDS_BYTES) != hipSuccess || per_cu < 1) {
            fprintf(stderr, "kernel_launch: occupancy query says %d blocks per CU\n", per_cu); per_cu = 1; }
#else
        for (int k = 0; k < NPH; ++k) if (hipFuncSetAttribute((const void*)phase_kernel(k), hipFuncAttributeMaxDynamicSharedMemorySize, LDS_BYTES) != hipSuccess) { fprintf(stderr, "kernel_launch: hipFuncSetAttribute failed\n"); grid = -1; return; }
        (void)per_cu;
#endif
        (void)hipGetLastError();
        grid = cus;
    }
    if (grid < 0) return;
    (void)hipMemsetAsync((char*)d_ws + WS_CTL, 0, CTL_ZERO_BYTES, stream);
    Args a{};
    for (int i = 0; i < 28; ++i) a.in[i] = (const float*)d_in[i];
    a.out = (float*)d_out; a.ws = (unsigned char*)d_ws;
#if MK_N_LAUNCHES == 1
    a.ph_lo = 0; a.ph_hi = NPH; a.li = 0;
    hipLaunchKernelGGL(mk_fwd, dim3(grid), dim3(NWAVES * 64), LDS_BYTES, stream, a);
#else
    for (int li = 0; li < NPH; ++li) { a.ph_lo = li; a.ph_hi = li + 1; a.li = li;
        hipLaunchKernelGGL(phase_kernel(li), dim3(grid), dim3(NWAVES * 64), LDS_BYTES, stream, a); }
#endif
}
```
